# Optimizing an MI355X kernel written in HIP

```python
import functools
import jax
import jax.numpy as jnp
from jax import lax
import numpy as np

D_MODEL = 1024
BATCH = 32
SEQ = 2048
DEPTH = 4

GRID_W = 64
CTX_LEN = 256
D_MIX = D_MODEL
GLA_W = D_MIX // 4
RET_W = D_MIX // 4
MLA_W = D_MIX - GLA_W - RET_W
GLA_DV = 64
GLA_HEADS = GLA_W // GLA_DV
GLA_DK = GLA_DV // 2
GLA_QK = GLA_HEADS * GLA_DK
GLA_GATE_RANK = 16
GLA_TAU = 16.0
RET_DV = 64
RET_HEADS = RET_W // RET_DV
RET_DK = RET_DV // 2
RET_QK = RET_HEADS * RET_DK
MLA_DV = 64
MLA_HEADS = MLA_W // MLA_DV
MLA_D_NOPE = 64
MLA_D_ROPE = 32
MLA_Q_RANK = D_MODEL // 4
MLA_KV_RANK = D_MODEL // 8
MLA_SCALE = (MLA_D_NOPE + MLA_D_ROPE) ** -0.5
CHUNK = 64
Q_BLOCK = 128
D_FF = 128 * ((8 * D_MODEL // 3 + 127) // 128)
CONV_W = 3
ROPE_BASE = 10000.0
EPS = 1e-6
ALPHA = (2 * DEPTH) ** 0.25
BETA = (8 * DEPTH) ** -0.25
ADA_INIT = 0.5
IN_SIZES = (GLA_QK, GLA_QK, GLA_W, 2 * GLA_GATE_RANK, GLA_W,
            RET_QK, RET_QK, RET_W, RET_W,
            MLA_Q_RANK, MLA_KV_RANK, MLA_D_ROPE)
D_IN = sum(IN_SIZES)

kernel_name = "hybrid_gla_retnet_mla_prefix_dit"


def _layer_norm(x, g, b):
    xf = x.astype(jnp.float32)
    mu = jnp.mean(xf, axis=-1, keepdims=True)
    var = jnp.mean(jnp.square(xf - mu), axis=-1, keepdims=True)
    return ((xf - mu) * lax.rsqrt(var + EPS) * g + b).astype(x.dtype)


def _rms_norm(x, g):
    xf = x.astype(jnp.float32)
    return xf * lax.rsqrt(jnp.mean(jnp.square(xf), axis=-1, keepdims=True) + EPS) * g


def _group_norm(x):
    xf = x.astype(jnp.float32)
    mu = jnp.mean(xf, axis=-1, keepdims=True)
    var = jnp.mean(jnp.square(xf - mu), axis=-1, keepdims=True)
    return (xf - mu) * lax.rsqrt(var + EPS)


def _heads(t, n):
    return t.reshape(t.shape[0], t.shape[1], n, -1)


def _merge(t):
    return t.reshape(t.shape[0], t.shape[1], -1)


def _rot_half(x, cos, sin):
    cos = cos.astype(x.dtype)
    sin = sin.astype(x.dtype)
    x1, x2 = jnp.split(x, 2, axis=-1)
    return jnp.concatenate([x1 * cos - x2 * sin, x1 * sin + x2 * cos], axis=-1)


def _axial_rope(x, row_cos, row_sin, col_cos, col_sin):
    xr, xc = jnp.split(x, 2, axis=-1)
    return jnp.concatenate([_rot_half(xr, row_cos, row_sin), _rot_half(xc, col_cos, col_sin)], axis=-1)


def _project(h, w_in):
    p = jnp.einsum('bld,de->ble', h, w_in)
    return jnp.split(p, np.cumsum(IN_SIZES)[:-1].tolist(), axis=-1)


def _to_chunks(t):
    b, l, h, d = t.shape
    return t.reshape(b, l // CHUNK, CHUNK, h, d).transpose(1, 0, 3, 2, 4)


def _from_chunks(t):
    n, b, h, c, d = t.shape
    return t.transpose(1, 0, 3, 2, 4).reshape(b, n * c, h, d)


def _gla_log_gate(lr, w2, b2):
    z = jnp.einsum('blr,re->ble', lr, w2) + b2
    return _heads(jax.nn.log_sigmoid(z.astype(jnp.float32)) / GLA_TAU, GLA_HEADS)


def _gla_scan(q, k, v, log_a, s0):
    f32 = jnp.float32
    qc, kc, vc, ac = tuple(_to_chunks(t.astype(f32)) for t in (q, k, v, log_a))
    tri = jnp.tril(jnp.ones((CHUNK, CHUNK), dtype=bool))[:, :, None]

    def step(s, inp):
        qi, ki, vi, ai = inp
        b = jnp.cumsum(ai, axis=2)
        diff = b[:, :, :, None, :] - b[:, :, None, :, :]
        decay = jnp.exp(jnp.where(tri, diff, -jnp.inf))
        att = jnp.einsum('bhtd,bhsd,bhtsd->bhts', qi, ki, decay)
        o = (jnp.einsum('bhtd,bhde->bhte', qi * jnp.exp(b), s)
             + jnp.einsum('bhts,bhse->bhte', att, vi))
        b_end = b[:, :, -1:, :]
        s = (s * jnp.exp(b_end)[:, :, 0, :, None]
             + jnp.einsum('bhsd,bhse->bhde', ki * jnp.exp(b_end - b), vi))
        return s, o

    s_fin, o = lax.scan(step, s0, (qc, kc, vc, ac))
    return _from_chunks(o), s_fin


def _ret_scan(log_g, q, k, v, s0):
    f32 = jnp.float32
    qc, kc, vc = tuple(_to_chunks(t.astype(f32)) for t in (q, k, v))
    idx = jnp.arange(CHUNK, dtype=f32)
    rel = idx[:, None] - idx[None, :]
    dmat = jnp.where(rel >= 0, jnp.exp(jnp.maximum(rel, 0.0) * log_g[:, None, None]), 0.0)
    q_dec = jnp.exp((idx + 1.0) * log_g[:, None])[..., None]
    k_dec = jnp.exp((CHUNK - 1.0 - idx) * log_g[:, None])[..., None]
    s_dec = jnp.exp(CHUNK * log_g)[:, None, None]

    def step(s, inp):
        qi, ki, vi = inp
        att = jnp.einsum('bhtd,bhsd->bhts', qi, ki) * dmat
        o = (jnp.einsum('bhtd,bhde->bhte', qi * q_dec, s)
             + jnp.einsum('bhts,bhse->bhte', att, vi))
        s = s * s_dec + jnp.einsum('bhsd,bhse->bhde', ki * k_dec, vi)
        return s, o

    s_fin, o = lax.scan(step, s0, (qc, kc, vc))
    return _from_chunks(o), s_fin


def _bidir_prefix(scan_f, scan_b, ctx_f, lat_f, ctx_b, lat_b, s0):
    flip = lambda ts: [jnp.flip(t, axis=1) for t in ts]
    oc_f, sc_f = scan_f(*ctx_f, s0)
    ol_f, _ = scan_f(*lat_f, sc_f)
    oc_b, sc_b = scan_b(*flip(ctx_b), s0)
    ol_b, _ = scan_b(*flip(lat_b), sc_b)
    return oc_f + jnp.flip(oc_b, axis=1), ol_f + jnp.flip(ol_b, axis=1)


def _mla_attend(qn, qr, kn, kr, v):
    s = (jnp.einsum('bqhd,bkhd->bhqk', qn, kn)
         + jnp.einsum('bqhr,bkr->bhqk', qr, kr)).astype(jnp.float32) * MLA_SCALE
    p = jax.nn.softmax(s, axis=-1).astype(v.dtype)
    return jnp.einsum('bhqk,bkhe->bqhe', p, v)


def _mla_blocks(qn, qr, kn, kr, v):
    b, s = qn.shape[0], qn.shape[1]
    nb = s // Q_BLOCK
    blk = lambda t: jnp.moveaxis(t.reshape(b, nb, Q_BLOCK, *t.shape[2:]), 1, 0)
    out = lax.map(lambda qs: _mla_attend(qs[0], qs[1], kn, kr, v), (blk(qn), blk(qr)))
    return jnp.moveaxis(out, 0, 1).reshape(b, s, MLA_HEADS, MLA_DV)


def _token_mixers(h_c, h_l, rope, w_in, gla_gate_w, gla_gate_b, gla_norm_g, ret_decay,
                  mla_q_norm_g, mla_kv_norm_g, mla_w_uq, mla_w_uk, mla_w_uv, need_ctx):
    ret_cos, ret_sin, row_cos, row_sin, col_cos, col_sin = rope
    b = h_l.shape[0]
    pc = _project(h_c, w_in)
    pl = _project(h_l, w_in)

    def gla_inputs(p):
        q = _heads(p[0], GLA_HEADS) * (GLA_DK ** -0.5)
        k = _heads(p[1], GLA_HEADS)
        v = _heads(p[2], GLA_HEADS)
        lr_f, lr_b = jnp.split(p[3], 2, axis=-1)
        a_f = _gla_log_gate(lr_f, gla_gate_w[0], gla_gate_b[0])
        a_b = _gla_log_gate(lr_b, gla_gate_w[1], gla_gate_b[1])
        return (q, k, v, a_f), (q, k, v, a_b)

    gc_f, gc_b = gla_inputs(pc)
    gl_f, gl_b = gla_inputs(pl)
    s0_gla = jnp.zeros((b, GLA_HEADS, GLA_DK, GLA_DV), jnp.float32)
    gla_c, gla_l = _bidir_prefix(_gla_scan, _gla_scan, gc_f, gl_f, gc_b, gl_b, s0_gla)
    gla_out = lambda o, p: _merge(_rms_norm(o, gla_norm_g) * jax.nn.silu(_heads(p[4], GLA_HEADS)))

    log_g = jax.nn.log_sigmoid(ret_decay.astype(jnp.float32))

    def ret_inputs(p, rotate):
        q = _heads(p[5], RET_HEADS)
        k = _heads(p[6], RET_HEADS) * (RET_DK ** -0.5)
        v = _heads(p[7], RET_HEADS)
        if rotate:
            q = _rot_half(q, ret_cos[:, None], ret_sin[:, None])
            k = _rot_half(k, ret_cos[:, None], ret_sin[:, None])
        return (q, k, v)

    rc = ret_inputs(pc, False)
    rl = ret_inputs(pl, True)
    s0_ret = jnp.zeros((b, RET_HEADS, RET_DK, RET_DV), jnp.float32)
    ret_c, ret_l = _bidir_prefix(functools.partial(_ret_scan, log_g[0]),
                                 functools.partial(_ret_scan, log_g[1]),
                                 rc, rl, rc, rl, s0_ret)
    ret_out = lambda o, p: _merge(_group_norm(o) * jax.nn.silu(_heads(p[8], RET_HEADS)))

    def mla_inputs(p, rotate):
        cq = _rms_norm(p[9], mla_q_norm_g)
        q = _heads(jnp.einsum('blr,re->ble', cq, mla_w_uq), MLA_HEADS)
        qn, qr = q[..., :MLA_D_NOPE], q[..., MLA_D_NOPE:]
        ckv = _rms_norm(p[10], mla_kv_norm_g)
        kn = _heads(jnp.einsum('blr,re->ble', ckv, mla_w_uk), MLA_HEADS)
        v = _heads(jnp.einsum('blr,re->ble', ckv, mla_w_uv), MLA_HEADS)
        kr = p[11]
        if rotate:
            qr = _axial_rope(qr, row_cos[:, None], row_sin[:, None], col_cos[:, None], col_sin[:, None])
            kr = _axial_rope(kr, row_cos, row_sin, col_cos, col_sin)
        return qn, qr, kn, kr, v

    qn_c, qr_c, kn_c, kr_c, v_c = mla_inputs(pc, False)
    qn_l, qr_l, kn_l, kr_l, v_l = mla_inputs(pl, True)
    mla_l = _mla_blocks(qn_l, qr_l,
                        jnp.concatenate([kn_l, kn_c], axis=1),
                        jnp.concatenate([kr_l, kr_c], axis=1),
                        jnp.concatenate([v_l, v_c], axis=1))
    m_l = jnp.concatenate([gla_out(gla_l, pl), ret_out(ret_l, pl), _merge(mla_l)], axis=-1).astype(h_l.dtype)
    if not need_ctx:
        return None, m_l
    mla_c = _mla_attend(qn_c, qr_c, kn_c, kr_c, v_c)
    m_c = jnp.concatenate([gla_out(gla_c, pc), ret_out(ret_c, pc), _merge(mla_c)], axis=-1).astype(h_c.dtype)
    return m_c, m_l


def _conv_ffn(h, w_up, conv_w, conv_b, w_down):
    u = jnp.einsum('bld,df->blf', h, w_up)
    l = u.shape[1]
    pad = CONV_W // 2
    up = jnp.pad(u, ((0, 0), (pad, pad), (0, 0)))
    u = sum(up[:, j:j + l] * conv_w[j] for j in range(CONV_W)) + conv_b
    a, g = jnp.split(u, 2, axis=-1)
    return jnp.einsum('blf,fd->bld', jax.nn.silu(a) * g, w_down)


def setup_inputs(seed: int = 0) -> dict:
    key = jax.random.key(seed)
    ks = jax.random.split(key, 28)
    f32 = jnp.float32
    nrm = lambda k, shape, s: jax.random.normal(k, shape, f32) * s
    L = DEPTH
    ret_base = jnp.log(2.0 ** (5.0 + jnp.arange(RET_HEADS, dtype=f32)) - 1.0)
    return {
        "x": nrm(ks[0], (BATCH, SEQ, D_MODEL), 1.0),
        "c": nrm(ks[1], (BATCH, D_MODEL), 1.0),
        "ctx": nrm(ks[2], (BATCH, CTX_LEN, D_MODEL), 1.0),
        "c_ctx": nrm(ks[3], (D_MODEL,), 1.0),
        "ada_w": nrm(ks[4], (L, D_MODEL, 6 * D_MODEL), ADA_INIT * D_MODEL ** -0.5),
        "ada_b": nrm(ks[5], (L, 6 * D_MODEL), 0.01),
        "w_in": nrm(ks[6], (L, D_MODEL, D_IN), D_MODEL ** -0.5),
        "gla_gate_w": nrm(ks[7], (L, 2, GLA_GATE_RANK, GLA_QK), GLA_GATE_RANK ** -0.5),
        "gla_gate_b": nrm(ks[8], (L, 2, GLA_QK), 0.1),
        "gla_norm_g": 1.0 + nrm(ks[9], (L, GLA_DV), 0.02),
        "ret_decay": ret_base + nrm(ks[10], (L, 2, RET_HEADS), 0.1),
        "mla_q_norm_g": 1.0 + nrm(ks[11], (L, MLA_Q_RANK), 0.02),
        "mla_kv_norm_g": 1.0 + nrm(ks[12], (L, MLA_KV_RANK), 0.02),
        "mla_w_uq": nrm(ks[13], (L, MLA_Q_RANK, MLA_HEADS * (MLA_D_NOPE + MLA_D_ROPE)), MLA_Q_RANK ** -0.5),
        "mla_w_uk": nrm(ks[14], (L, MLA_KV_RANK, MLA_HEADS * MLA_D_NOPE), MLA_KV_RANK ** -0.5),
        "mla_w_uv": nrm(ks[15], (L, MLA_KV_RANK, MLA_HEADS * MLA_DV), MLA_KV_RANK ** -0.5),
        "w_out": nrm(ks[16], (L, D_MIX, D_MODEL), BETA * D_MIX ** -0.5),
        "ln1_g": 1.0 + nrm(ks[17], (L, D_MODEL), 0.02),
        "ln1_b": nrm(ks[18], (L, D_MODEL), 0.02),
        "ffn_up": nrm(ks[19], (L, D_MODEL, 2 * D_FF), D_MODEL ** -0.5),
        "ffn_conv_w": nrm(ks[20], (L, CONV_W, 2 * D_FF), CONV_W ** -0.5),
        "ffn_conv_b": nrm(ks[21], (L, 2 * D_FF), 0.01),
        "ffn_down": nrm(ks[22], (L, D_FF, D_MODEL), BETA * D_FF ** -0.5),
        "ln2_g": 1.0 + nrm(ks[23], (L, D_MODEL), 0.02),
        "ln2_b": nrm(ks[24], (L, D_MODEL), 0.02),
    }


def reference(x, c, ctx, c_ctx, ada_w, ada_b, w_in, gla_gate_w, gla_gate_b, gla_norm_g, ret_decay,
              mla_q_norm_g, mla_kv_norm_g, mla_w_uq, mla_w_uk, mla_w_uv, w_out, ln1_g, ln1_b,
              ffn_up, ffn_conv_w, ffn_conv_b, ffn_down, ln2_g, ln2_b):
    f32 = jnp.float32
    seq = x.shape[1]
    rows_n = seq // GRID_W
    rows = jnp.repeat(jnp.arange(rows_n, dtype=f32), GRID_W)
    cols = jnp.tile(jnp.arange(GRID_W, dtype=f32), rows_n)
    pos = jnp.arange(seq, dtype=f32)
    ret_inv = 1.0 / (ROPE_BASE ** jnp.linspace(0.0, 1.0, RET_DK // 2, dtype=f32))
    ret_ang = pos[:, None] * ret_inv
    n_ax = MLA_D_ROPE // 4
    ax_inv = ROPE_BASE ** (-jnp.arange(n_ax, dtype=f32) / n_ax)
    row_ang = rows[:, None] * ax_inv
    col_ang = cols[:, None] * ax_inv
    rope = (jnp.cos(ret_ang), jnp.sin(ret_ang), jnp.cos(row_ang), jnp.sin(row_ang),
            jnp.cos(col_ang), jnp.sin(col_ang))

    for i in range(DEPTH):
        need_ctx = i < DEPTH - 1
        mod_l = jnp.einsum('bd,de->be', jax.nn.silu(c), ada_w[i]) + ada_b[i]
        mod_c = jnp.einsum('d,de->e', jax.nn.silu(c_ctx), ada_w[i]) + ada_b[i]
        sh1_l, sc1_l, g1_l, sh2_l, sc2_l, g2_l = [m[:, None, :] for m in jnp.split(mod_l, 6, axis=-1)]
        sh1_c, sc1_c, g1_c, sh2_c, sc2_c, g2_c = jnp.split(mod_c, 6, axis=-1)

        h_l = x * (1.0 + sc1_l) + sh1_l
        h_c = ctx * (1.0 + sc1_c) + sh1_c
        m_c, m_l = _token_mixers(h_c, h_l, rope, w_in[i], gla_gate_w[i], gla_gate_b[i], gla_norm_g[i],
                                 ret_decay[i], mla_q_norm_g[i], mla_kv_norm_g[i], mla_w_uq[i],
                                 mla_w_uk[i], mla_w_uv[i], need_ctx)
        x = _layer_norm(ALPHA * x + g1_l * jnp.einsum('ble,ed->bld', m_l, w_out[i]), ln1_g[i], ln1_b[i])
        f_l = _conv_ffn(x * (1.0 + sc2_l) + sh2_l, ffn_up[i], ffn_conv_w[i], ffn_conv_b[i], ffn_down[i])
        x = _layer_norm(ALPHA * x + g2_l * f_l, ln2_g[i], ln2_b[i])
        if need_ctx:
            ctx = _layer_norm(ALPHA * ctx + g1_c * jnp.einsum('ble,ed->bld', m_c, w_out[i]), ln1_g[i], ln1_b[i])
            f_c = _conv_ffn(ctx * (1.0 + sc2_c) + sh2_c, ffn_up[i], ffn_conv_w[i], ffn_conv_b[i], ffn_down[i])
            ctx = _layer_norm(ALPHA * ctx + g2_c * f_c, ln2_g[i], ln2_b[i])
    return x
```

```cpp
#include <hip/hip_runtime.h>
#include <hip/hip_cooperative_groups.h>
#include <cstdio>
#include <cmath>
namespace cg = cooperative_groups;

#ifndef MULTI_LAUNCH
#define MULTI_LAUNCH 0
#endif

typedef unsigned short bf16_t;
typedef short bf16x8 __attribute__((ext_vector_type(8)));
typedef short bf16x4 __attribute__((ext_vector_type(4)));
typedef float f32x4 __attribute__((ext_vector_type(4)));
typedef float f32x16 __attribute__((ext_vector_type(16)));
typedef unsigned u32x4 __attribute__((ext_vector_type(4)));
typedef unsigned u32x2 __attribute__((ext_vector_type(2)));

constexpr int NLAT = 65536, NCTX = 8192, MTOT = 73728, DM = 1024, DIN = 1984, DFF = 2816;
constexpr int NTHREADS = 512;
constexpr int LDS_BYTES = 140 * 1024;
constexpr float EPS = 1e-6f;
constexpr float ALPHA = 1.681792830507429f;
constexpr int NPL = 10;
constexpr int NPHASE = 2 + 4 * NPL;
constexpr int GQ = 0, GK = 128, GV = 256, GLR = 512, GG = 544, RQ = 800, RK = 928, RV = 1056, RG = 1312, MCQ = 1568, MCKV = 1824, MKR = 1952;
constexpr int USTR = 264;

struct Params {
  const float *x, *c, *ctx, *c_ctx, *ada_w, *ada_b, *w_in, *gate_w, *gate_b, *gla_g, *ret_decay, *qn_g, *kvn_g, *w_uq, *w_uk, *w_uv,
      *w_out, *ln1_g, *ln1_b, *ffn_up, *conv_w, *conv_b, *ffn_down, *ln2_g, *ln2_b;
  float* out;
  float* X; bf16_t* H; bf16_t* P; bf16_t* HA; bf16_t* HU; bf16_t* ACT; bf16_t* Q; bf16_t* Kn; bf16_t* Vt; bf16_t* Kr; bf16_t* St; float* dec; float* rstd; float* lnst;
  float* mod; float* ropetab; float* rettab;
  bf16_t *Wt_in, *Wt_uq, *Wt_uk, *Wt_uv, *Wt_out, *Wt_up, *Wt_down;
  unsigned* bar; unsigned long long* xch; unsigned* cnt;
  double ax_inv[8]; double ret_inv[16];
};

typedef __bf16 bf2_t __attribute__((ext_vector_type(2)));
typedef float f2_t __attribute__((ext_vector_type(2)));
__device__ __forceinline__ unsigned pk2(float lo, float hi) { const f2_t v = {lo, hi}; return __builtin_bit_cast(unsigned, __builtin_convertvector(v, bf2_t)); }
__device__ __forceinline__ bf16_t f2bf(float f) { return (bf16_t)(pk2(f, 0.f) & 0xffffu); }
__device__ __forceinline__ float bf2f(bf16_t v) { return __uint_as_float(((unsigned)v) << 16); }
__device__ __forceinline__ float bflo(unsigned w) { return __uint_as_float(w << 16); }
__device__ __forceinline__ float bfhi(unsigned w) { return __uint_as_float(w & 0xffff0000u); }
__device__ __forceinline__ float silu_f(float v) { return v * __builtin_amdgcn_rcpf(1.f + __expf(-v)); }
__device__ __forceinline__ float logsigmoid_f(float z) { return fminf(z, 0.f) - __logf(1.f + __expf(-fabsf(z))); }
__device__ __forceinline__ int otid_impl(int w0) { int t; asm volatile("v_mbcnt_lo_u32_b32 %0, -1, 0\n\tv_mbcnt_hi_u32_b32 %0, -1, %0" : "=v"(t)); return w0 * 64 + t; }
#define otid() otid_impl(w0)
__device__ __forceinline__ int row_bi(int r) { return r < NLAT ? (r >> 11) : 32; }

constexpr int BM = 256, BK = 64, HALF = 128, HT = HALF * BK;
__device__ __forceinline__ int lds_byte(int r, int c) {
  int st = (r >> 4) * 2 + (c >> 5), rr = r & 15, cc = c & 31, ob = rr * 64 + cc * 2;
  return st * 1024 + (ob ^ (((ob >> 9) & 1) << 5));
}
__device__ __forceinline__ void stage_rc(int b, int& R, int& C) {
  int st = b / 1024, sb = b % 1024, swz = sb ^ (((sb >> 9) & 1) << 5);
  R = (st >> 1) * 16 + swz / 64; C = (st & 1) * 32 + (swz % 64) / 2;
}
__device__ __forceinline__ bool tile_next(long L, int nM, int nN, int& pm, int& pn) {
  int nwg = nM * nN; if (L >= nwg) return false;
  int wgid = (int)L; { int q = nwg / 8, r = nwg % 8, xcd = wgid % 8, off = wgid / 8; wgid = (xcd < r ? xcd * (q + 1) : r * (q + 1) + (xcd - r) * q) + off; }
  int nig = 8 * nN, gid = wgid / nig, fm = gid * 8, gsz = min(nM - fm, 8);
  pm = fm + ((wgid % nig) % gsz); pn = (wgid % nig) / gsz; return true;
}

__device__ __forceinline__ bool tile_next_panel(long L, int nM, int& pm, int& pn) {
  const int r = (int)(L >> 8), c = (int)(L & 255);
  pm = r * 64 + (c & 7) * 8 + (c >> 5); pn = (c >> 3) & 3;
  return pm < nM;
}
template <bool OVL, bool PANEL = false, class Epi>
__device__ __forceinline__ void gemm_phase(const bf16_t* __restrict__ A, long lda, const bf16_t* __restrict__ Bt, long ldb, int nM, int nN, int K,
                                           const Epi& epi, bf16_t* shm, int w0) {
#define SA(b, h) (shm + ((b) * 2 + (h)) * HT)
#define SB(b, h) (shm + (4 + (b) * 2 + (h)) * HT)
#define STAGE(Pp, BASE, LD, OFF, br, kt) do { const char* _gp = (const char*)((BASE) + ((long)(br) * (LD) + (long)(kt) * BK)); \
    unsigned _o = (OFF); asm volatile("" : "+v"(_o));     \
    for (int _i = 0; _i < 2; ++_i) { \
      __builtin_amdgcn_global_load_lds((const unsigned*)(_gp + (long)_i * 128 * (LD) + _o), \
        (__attribute__((address_space(3))) unsigned*)((char*)(Pp) + tid * 16 + _i * 8192), 16, 0, 0); } } while (0)
#define LDA(dst, b, h) for (int m = 0; m < 4; ++m) for (int k = 0; k < 2; ++k) \
    dst[m][k] = *reinterpret_cast<const bf16x8*>((char*)SA(b, h) + a_thr + (m * 2 + k) * 1024)
#define LDB(dst, b, h) for (int n = 0; n < 2; ++n) for (int k = 0; k < 2; ++k) \
    dst[n][k] = *reinterpret_cast<const bf16x8*>((char*)SB(b, h) + b_thr + (n * 2 + k) * 1024)
#define MMA(ai, bj, At, Btf) do { __builtin_amdgcn_s_setprio(1); \
    for (int m = 0; m < 4; ++m) for (int n = 0; n < 2; ++n) for (int k = 0; k < 2; ++k) \
      acc[ai][bj][m][n] = __builtin_amdgcn_mfma_f32_16x16x32_bf16(Btf[n][k], At[m][k], acc[ai][bj][m][n], 0, 0, 0); \
    __builtin_amdgcn_s_setprio(0); } while (0)
#define WAIT_V(n) asm volatile("s_waitcnt vmcnt(" #n ")" ::: "memory")
#define WAIT_L(n) asm volatile("s_waitcnt lgkmcnt(" #n ")" ::: "memory")
#define BAR __builtin_amdgcn_s_barrier()
#define SCHED __builtin_amdgcn_sched_barrier(0)
  const int tid = otid();
  const int wid = tid >> 6, lane = tid & 63, wr = wid >> 2, wc = wid & 3, fr = lane & 15, fq = lane >> 4;
  const int nt = K / BK;
  const int thr_sw = (fr * 64 + fq * 16) ^ ((fr >> 3) << 5); const int a_thr = wr * 8192 + thr_sw, b_thr = wc * 4096 + thr_sw;
  unsigned aoff, boff;
  { int _r, _c; stage_rc(tid * 16, _r, _c); aoff = (unsigned)((_r * lda + _c) * 2); boff = (unsigned)((_r * ldb + _c) * 2); }
  int pm, pn;
  bool have = PANEL ? tile_next_panel((long)blockIdx.x, nM, pm, pn) : tile_next((long)blockIdx.x, nM, nN, pm, pn);
  if (have) { const int brow = pm * BM, bcol = pn * BM;
    STAGE(SB(0, 0), Bt, ldb, boff, bcol, 0); STAGE(SA(0, 0), A, lda, aoff, brow, 0);
    STAGE(SB(0, 1), Bt, ldb, boff, bcol + HALF, 0); STAGE(SA(0, 1), A, lda, aoff, brow + HALF, 0); }
  for (int it = 0; have; ++it) {
    const int brow = pm * BM, bcol = pn * BM;
    f32x4 acc[2][2][4][2];
#pragma unroll
    for (int a0 = 0; a0 < 2; ++a0)
#pragma unroll
      for (int a1 = 0; a1 < 2; ++a1)
#pragma unroll
        for (int a2 = 0; a2 < 4; ++a2)
#pragma unroll
          for (int a3 = 0; a3 < 2; ++a3) acc[a0][a1][a2][a3] = (f32x4){0.f, 0.f, 0.f, 0.f};
    bf16x8 At[4][2], B0[2][2], B1[2][2];
    if (wr == 1) BAR;
    WAIT_V(4); BAR;
    STAGE(SB(1, 0), Bt, ldb, boff, bcol, 1); STAGE(SA(1, 0), A, lda, aoff, brow, 1); STAGE(SB(1, 1), Bt, ldb, boff, bcol + HALF, 1);
    WAIT_V(6); BAR;
    for (int t = 0; t < nt - 2; t += 2) {
      LDB(B0, 0, 0); SCHED; LDA(At, 0, 0); STAGE(SA(1, 1), A, lda, aoff, brow + HALF, t + 1);
      WAIT_L(8); BAR; WAIT_L(0); MMA(0, 0, At, B0); BAR; SCHED;
      LDB(B1, 0, 1); STAGE(SB(0, 0), Bt, ldb, boff, bcol, t + 2);
      BAR; WAIT_L(0); MMA(0, 1, At, B1); BAR;
      LDA(At, 0, 1); STAGE(SA(0, 0), A, lda, aoff, brow, t + 2);
      BAR; WAIT_L(0); MMA(1, 0, At, B0); BAR; SCHED;
      STAGE(SB(0, 1), Bt, ldb, boff, bcol + HALF, t + 2);
      WAIT_V(6); BAR; MMA(1, 1, At, B1); BAR;
      LDB(B0, 1, 0); SCHED; LDA(At, 1, 0); STAGE(SA(0, 1), A, lda, aoff, brow + HALF, t + 2);
      WAIT_L(8); BAR; WAIT_L(0); MMA(0, 0, At, B0); BAR; SCHED;
      LDB(B1, 1, 1); STAGE(SB(1, 0), Bt, ldb, boff, bcol, t + 3);
      BAR; WAIT_L(0); MMA(0, 1, At, B1); BAR;
      LDA(At, 1, 1); STAGE(SA(1, 0), A, lda, aoff, brow, t + 3);
      BAR; WAIT_L(0); MMA(1, 0, At, B0); BAR; SCHED;
      STAGE(SB(1, 1), Bt, ldb, boff, bcol + HALF, t + 3);
      WAIT_V(6); BAR; MMA(1, 1, At, B1); BAR;
    }
    { LDB(B0, 0, 0); LDA(At, 0, 0); STAGE(SA(1, 1), A, lda, aoff, brow + HALF, nt - 1);
      BAR; WAIT_L(0); MMA(0, 0, At, B0); BAR;
      LDB(B1, 0, 1); BAR; WAIT_L(0); MMA(0, 1, At, B1); BAR;
      LDA(At, 0, 1); WAIT_V(4); BAR; WAIT_L(0); MMA(1, 0, At, B0); MMA(1, 1, At, B1); BAR; }
    { LDB(B0, 1, 0); LDA(At, 1, 0); WAIT_V(2); BAR; WAIT_L(0); MMA(0, 0, At, B0); BAR;
      LDB(B1, 1, 1); WAIT_V(0); BAR; WAIT_L(0); MMA(0, 1, At, B1); BAR;
      LDA(At, 1, 1); BAR; WAIT_L(0); MMA(1, 0, At, B0); MMA(1, 1, At, B1); BAR; }
    if (wr == 0) BAR;
    const int cpm = pm, cpn = pn;
    have = PANEL ? tile_next_panel((long)(it + 1) * gridDim.x + blockIdx.x, nM, pm, pn) : tile_next((long)(it + 1) * gridDim.x + blockIdx.x, nM, nN, pm, pn);
    if (OVL && have) { const int nbrow = pm * BM, nbcol = pn * BM;
      STAGE(SB(0, 0), Bt, ldb, boff, nbcol, 0); STAGE(SA(0, 0), A, lda, aoff, nbrow, 0);
      STAGE(SB(0, 1), Bt, ldb, boff, nbcol + HALF, 0); STAGE(SA(0, 1), A, lda, aoff, nbrow + HALF, 0); }
    asm volatile("s_nop 15\n\ts_nop 15" ::: "memory");
    { const int tid2 = otid(); epi(acc, cpm, cpn, wr, wc, fr, fq, shm, tid2); }
    if (OVL) WAIT_V(0);
    else if (have) { const int nbrow = pm * BM, nbcol = pn * BM;
      STAGE(SB(0, 0), Bt, ldb, boff, nbcol, 0); STAGE(SA(0, 0), A, lda, aoff, nbrow, 0);
      STAGE(SB(0, 1), Bt, ldb, boff, nbcol + HALF, 0); STAGE(SA(0, 1), A, lda, aoff, nbrow + HALF, 0); }
  }
  __syncthreads();
#undef SA
#undef SB
#undef STAGE
#undef LDA
#undef LDB
#undef MMA
}

#define EPI_LOOP for (int ai = 0; ai < 2; ++ai) for (int bj = 0; bj < 2; ++bj) for (int m = 0; m < 4; ++m) for (int n = 0; n < 2; ++n)
#define EPI_RC asm volatile("" ::: "memory"); const int row = pm * 256 + ai * 128 + wr * 64 + m * 16 + fr; const int col = pn * 256 + bj * 128 + wc * 32 + n * 16 + fq * 4; const f32x4 v = acc[ai][bj][m][n];

struct EpiP {
  bf16_t* P;
  __device__ __forceinline__ void operator()(const f32x4 (&acc)[2][2][4][2], int pm, int pn, int wr, int wc, int fr, int fq, bf16_t* shm, int tid) const {
#pragma unroll
    EPI_LOOP { EPI_RC
      if (col < DIN) { u32x2 w; w.x = pk2(v[0], v[1]); w.y = pk2(v[2], v[3]); *(u32x2*)(P + (long)row * DIN + col) = w; } }
  }
};
struct EpiQ {
  bf16_t* Q; const float* rstd;
  __device__ __forceinline__ void operator()(const f32x4 (&acc)[2][2][4][2], int pm, int pn, int wr, int wc, int fr, int fq, bf16_t* shm, int tid) const {
#pragma unroll
    EPI_LOOP { EPI_RC
      const float s = rstd[2 * row] * (0.10206207261596577f * 1.4426950408889634f);
      u32x2 w; w.x = pk2(v[0] * s, v[1] * s); w.y = pk2(v[2] * s, v[3] * s); *(u32x2*)(Q + (long)row * 768 + col) = w; }
  }
};
struct EpiK {
  bf16_t* Kn; const float* rstd;
  __device__ __forceinline__ void operator()(const f32x4 (&acc)[2][2][4][2], int pm, int pn, int wr_, int wc_, int fr_, int fq_, bf16_t* shm, int tid) const {
    const int wr = tid >> 8, wc = (tid >> 6) & 3, fr = tid & 15, fq = (tid >> 4) & 3;
#pragma unroll
    EPI_LOOP { EPI_RC
      const float s = rstd[2 * row + 1];
      int b, key; if (row < NLAT) { b = row >> 11; key = row & 2047; } else { b = (row - NLAT) >> 8; key = 2048 + ((row - NLAT) & 255); }
      const int h = col >> 6, d = col & 63;
      u32x2 w; w.x = pk2(v[0] * s, v[1] * s); w.y = pk2(v[2] * s, v[3] * s);
      *(u32x2*)(Kn + (((long)(b * 8 + h) * 2304 + key) << 6) + d) = w; }
  }
};
struct EpiVt {
  bf16_t* Vt; const float* rstd;
  __device__ __forceinline__ void operator()(const f32x4 (&acc)[2][2][4][2], int pm, int pn, int wr, int wc, int fr, int fq, bf16_t* shm, int tid) const {
#pragma unroll
    for (int bj = 0; bj < 2; ++bj)
#pragma unroll
      for (int n = 0; n < 2; ++n) {
        asm volatile("" ::: "memory");
        const int col = pn * 256 + bj * 128 + wc * 32 + n * 16 + fq * 4;
        int b, key; if (col < NLAT) { b = col >> 11; key = col & 2047; } else { b = (col - NLAT) >> 8; key = 2048 + ((col - NLAT) & 255); }
        const float s0 = rstd[2 * col + 1], s1 = rstd[2 * col + 3], s2 = rstd[2 * col + 5], s3 = rstd[2 * col + 7];
        bf16_t* base = Vt + ((long)(b * 512 + pm * 256 + wr * 64 + fr)) * 2304 + key;
#pragma unroll
        for (int ai = 0; ai < 2; ++ai)
#pragma unroll
          for (int m = 0; m < 4; ++m) {
            const f32x4 v = acc[ai][bj][m][n];
            u32x2 w; w.x = pk2(v[0] * s0, v[1] * s1); w.y = pk2(v[2] * s2, v[3] * s3);
            *(u32x2*)(base + (long)(ai * 128 + m * 16) * 2304) = w;
          }
      }
  }
};
struct EpiRes {
  float* X; const float* g; const float* stats; const float* lng; const float* lnb;
  __device__ __forceinline__ void operator()(const f32x4 (&acc)[2][2][4][2], int pm, int pn, int wr_, int wc_, int fr_, int fq_, bf16_t* shm, int tid) const {
    const int wr = tid >> 8, wc = (tid >> 6) & 3, fr = tid & 15, fq = (tid >> 4) & 3;
#pragma unroll
    for (int bj = 0; bj < 2; ++bj)
#pragma unroll
      for (int n = 0; n < 2; ++n) {
        asm volatile("" ::: "memory");
        const int col = pn * 256 + bj * 128 + wc * 32 + n * 16 + fq * 4;
        f32x4 lg = {1.f, 1.f, 1.f, 1.f}, lb = {0.f, 0.f, 0.f, 0.f};
        if (stats) { lg = *(const f32x4*)(lng + col); lb = *(const f32x4*)(lnb + col); }
#pragma unroll
        for (int ai = 0; ai < 2; ++ai)
#pragma unroll
          for (int m = 0; m < 4; ++m) {
            const int row = pm * 256 + ai * 128 + wr * 64 + m * 16 + fr;
            const f32x4 v = acc[ai][bj][m][n];
            const f32x4 gv = *(const f32x4*)(g + (long)row_bi(row) * 6144 + col);
            f32x4* xp = (f32x4*)(X + (long)row * DM + col);
            f32x4 xv = *xp;
            if (stats) { const float mu = stats[2 * row], rs = stats[2 * row + 1]; xv = (xv - mu) * rs * lg + lb; }
            xv = xv * ALPHA + gv * v; *xp = xv;
          }
      }
  }
};
struct EpiResLN {
  const Params& p; int l; int fdown;
  __device__ __forceinline__ void operator()(f32x4 (&acc)[2][2][4][2], int pm, int pn, int wr_, int wc_, int fr_, int fq_, bf16_t* shm, int tid) const {
    const int wr = tid >> 8, wc = (tid >> 6) & 3, fr = tid & 15, fq = (tid >> 4) & 3;
    const bool last = (l == 3);
    const float* modl = p.mod + (long)l * 33 * 6144;
    float* X = p.X; float* lnst = p.lnst; bf16_t* H = p.H; unsigned long long* xch = p.xch; unsigned* cnt = p.cnt;
    const float* g = modl + (fdown ? 5120 : 2048);
    const float* stats = (!fdown && l == 0) ? nullptr : p.lnst;
    const float* lng = fdown ? p.ln1_g + l * 1024 : p.ln2_g + (l - 1) * 1024;
    const float* lnb = fdown ? p.ln1_b + l * 1024 : p.ln2_b + (l - 1) * 1024;
    const float* ng = fdown ? p.ln2_g + l * 1024 : p.ln1_g + l * 1024;
    const float* nb = fdown ? p.ln2_b + l * 1024 : p.ln1_b + l * 1024;
    const float* msh = fdown ? p.mod + (long)(l + 1) * 33 * 6144 : modl + 3072;
    const float* msc = fdown ? p.mod + (long)(l + 1) * 33 * 6144 + 1024 : modl + 4096;
    bf16_t* HA = fdown ? nullptr : p.HA;
    float* outp = (fdown && last) ? p.out : nullptr;
    const unsigned gen = (unsigned)(2 * l + 1 + fdown);
    f2_t* red = (f2_t*)((char*)shm + 128 * 1024);
    f2_t* rst = (f2_t*)((char*)shm + 128 * 1024 + 8192);
    float s1[8], s2[8];
#pragma unroll
    for (int i = 0; i < 8; ++i) { s1[i] = 0.f; s2[i] = 0.f; }
#pragma unroll
    for (int bj = 0; bj < 2; ++bj)
#pragma unroll
      for (int n = 0; n < 2; ++n) {
        asm volatile("" ::: "memory");
        const int col = pn * 256 + bj * 128 + wc * 32 + n * 16 + fq * 4;
        f32x4 lg = {1.f, 1.f, 1.f, 1.f}, lb = {0.f, 0.f, 0.f, 0.f};
        if (stats) { lg = *(const f32x4*)(lng + col); lb = *(const f32x4*)(lnb + col); }
#pragma unroll
        for (int ai = 0; ai < 2; ++ai)
#pragma unroll
          for (int m = 0; m < 4; ++m) {
            const int row = pm * 256 + ai * 128 + wr * 64 + m * 16 + fr;
            const f32x4 v = acc[ai][bj][m][n];
            const f32x4 gv = *(const f32x4*)(g + (long)row_bi(row) * 6144 + col);
            f32x4* xp = (f32x4*)(X + (long)row * DM + col);
            f32x4 xv = *xp;
            if (stats) { const float mu = stats[2 * row], rs = stats[2 * row + 1]; xv = (xv - mu) * rs * lg + lb; }
            xv = xv * ALPHA + gv * v; *xp = xv;
            acc[ai][bj][m][n] = xv;
            s1[ai * 4 + m] += (xv[0] + xv[1]) + (xv[2] + xv[3]);
            s2[ai * 4 + m] += (xv[0] * xv[0] + xv[1] * xv[1]) + (xv[2] * xv[2] + xv[3] * xv[3]);
          }
      }
#pragma unroll
    for (int i = 0; i < 8; ++i) {
      s1[i] += __shfl_xor(s1[i], 16); s1[i] += __shfl_xor(s1[i], 32);
      s2[i] += __shfl_xor(s2[i], 16); s2[i] += __shfl_xor(s2[i], 32);
      if (fq == 0) red[((i >> 2) * 128 + wr * 64 + (i & 3) * 16 + fr) * 4 + wc] = (f2_t){s1[i], s2[i]};
    }
    __syncthreads();
    if (tid < 256) {
      const f2_t a = red[tid * 4], b = red[tid * 4 + 1], c = red[tid * 4 + 2], d = red[tid * 4 + 3];
      const f2_t t = {(a[0] + b[0]) + (c[0] + d[0]), (a[1] + b[1]) + (c[1] + d[1])};
      __hip_atomic_store(xch + ((long)pm * 4 + pn) * 256 + tid, __builtin_bit_cast(unsigned long long, t), __ATOMIC_RELAXED, __HIP_MEMORY_SCOPE_AGENT);
    }
    asm volatile("s_waitcnt vmcnt(0)" ::: "memory");
    __syncthreads();
    if (tid == 0) {
      __hip_atomic_fetch_add(cnt + pm * 16, 1u, __ATOMIC_RELAXED, __HIP_MEMORY_SCOPE_AGENT);
      unsigned sp = 0;
      while (__hip_atomic_load(cnt + pm * 16, __ATOMIC_RELAXED, __HIP_MEMORY_SCOPE_AGENT) < 4u * gen) { __builtin_amdgcn_s_sleep(1); if (++sp > (1u << 22)) break; }
    }
    __syncthreads();
    if (tid < 256) {
      float S1 = 0.f, S2 = 0.f;
#pragma unroll
      for (int q = 0; q < 4; ++q) { const f2_t t = __builtin_bit_cast(f2_t, __hip_atomic_load(xch + ((long)pm * 4 + q) * 256 + tid, __ATOMIC_RELAXED, __HIP_MEMORY_SCOPE_AGENT)); S1 += t[0]; S2 += t[1]; }
      const float mu = S1 * (1.f / 1024.f), var = fmaxf(S2 * (1.f / 1024.f) - mu * mu, 0.f), rs = rsqrtf(var + EPS);
      rst[tid] = (f2_t){mu, rs};
      if (pn == 0 && !outp) { lnst[2 * (pm * 256 + tid)] = mu; lnst[2 * (pm * 256 + tid) + 1] = rs; }
    }
    __syncthreads();
#pragma unroll
    for (int bj = 0; bj < 2; ++bj)
#pragma unroll
      for (int n = 0; n < 2; ++n) {
        asm volatile("" ::: "memory");
        const int col = pn * 256 + bj * 128 + wc * 32 + n * 16 + fq * 4;
        const f32x4 gg = *(const f32x4*)(ng + col), bb = *(const f32x4*)(nb + col);
#pragma unroll
        for (int ai = 0; ai < 2; ++ai)
#pragma unroll
          for (int m = 0; m < 4; ++m) {
            const int rl = ai * 128 + wr * 64 + m * 16 + fr, row = pm * 256 + rl;
            const f2_t st = rst[rl];
            f32x4 y = (acc[ai][bj][m][n] - st[0]) * st[1] * gg + bb;
            if (outp) { *(f32x4*)(outp + (long)row * DM + col) = y; }
            else {
              const long mo = (long)row_bi(row) * 6144 + col;
              const f32x4 sh = *(const f32x4*)(msh + mo), sc = *(const f32x4*)(msc + mo);
              y = y * (sc + 1.f) + sh;
              u32x2 w; w.x = pk2(y[0], y[1]); w.y = pk2(y[2], y[3]);
              *(u32x2*)(H + (long)row * DM + col) = w;
              if (HA && (rl == 0 || rl == 255)) *(u32x2*)(HA + (long)(pm * 2 + (rl == 255)) * DM + col) = w;
            }
          }
      }
  }
};
struct EpiU {
  bf16_t* U;
  __device__ __forceinline__ void operator()(const f32x4 (&acc)[2][2][4][2], int pm, int pn, int wr, int wc, int fr, int fq, bf16_t* shm, int tid) const {
#pragma unroll
    EPI_LOOP { EPI_RC
      u32x2 w; w.x = pk2(v[0], v[1]); w.y = pk2(v[2], v[3]); *(u32x2*)(U + (long)row * 5632 + col) = w; }
  }
};

struct EpiConv {
  bf16_t* ACT; const bf16_t* HU; const float* cw; const float* cb;
  __device__ __forceinline__ void operator()(const f32x4 (&acc)[2][2][4][2], int pm, int pn, int wr_, int wc_, int fr_, int fq_, bf16_t* shm, int tid) const {
    bf16_t* Us = shm;
    const int wr = tid >> 8, wc = (tid >> 6) & 3, fr = tid & 15, fq = (tid >> 4) & 3;
#pragma unroll
    for (int ai = 0; ai < 2; ++ai)
#pragma unroll
      for (int bj = 0; bj < 2; ++bj)
#pragma unroll
        for (int m = 0; m < 4; ++m)
#pragma unroll
          for (int n = 0; n < 2; ++n) {
            const f32x4 v = acc[ai][bj][m][n];
            u32x2 w; w.x = pk2(v[0], v[1]); w.y = pk2(v[2], v[3]);
            *(u32x2*)(Us + (ai * 128 + wr * 64 + m * 16 + fr + 1) * USTR + bj * 128 + wc * 32 + n * 16 + fq * 4) = w;
          }
    if (tid < 64) {
      const int after = tid >> 5, c = (tid & 31) * 8;
      u32x4 hv = {0, 0, 0, 0};
      if (pm < 256) {
        if (!after && (pm & 7) != 0) hv = *(const u32x4*)(HU + (long)((pm - 1) * 2 + 1) * 5632 + pn * 256 + c);
        if (after && ((pm + 1) & 7) != 0) hv = *(const u32x4*)(HU + (long)((pm + 1) * 2) * 5632 + pn * 256 + c);
      }
      *(u32x4*)(Us + (after ? 257 : 0) * USTR + c) = hv;
    }
    __syncthreads();
    {
      const int cg = tid & 15, rs = tid >> 4, f0 = pn * 128 + cg * 8;
      float wa[3][8], wg[3][8], ba[8], bg[8];
#pragma unroll
      for (int t = 0; t < 3; ++t)
#pragma unroll
        for (int e = 0; e < 8; e += 4) {
          const f32x4 x = *(const f32x4*)(cw + t * 5632 + f0 + e), y = *(const f32x4*)(cw + t * 5632 + 2816 + f0 + e);
          wa[t][e] = x[0]; wa[t][e + 1] = x[1]; wa[t][e + 2] = x[2]; wa[t][e + 3] = x[3];
          wg[t][e] = y[0]; wg[t][e + 1] = y[1]; wg[t][e + 2] = y[2]; wg[t][e + 3] = y[3];
        }
#pragma unroll
      for (int e = 0; e < 8; e += 4) {
        const f32x4 x = *(const f32x4*)(cb + f0 + e), y = *(const f32x4*)(cb + 2816 + f0 + e);
        ba[e] = x[0]; ba[e + 1] = x[1]; ba[e + 2] = x[2]; ba[e + 3] = x[3]; bg[e] = y[0]; bg[e + 1] = y[1]; bg[e + 2] = y[2]; bg[e + 3] = y[3];
      }
      const bf16_t* up = Us + (rs * 8) * USTR + cg * 8;
      u32x4 a0 = *(const u32x4*)(up), g0 = *(const u32x4*)(up + 128), a1 = *(const u32x4*)(up + USTR), g1 = *(const u32x4*)(up + USTR + 128);
      bf16_t* outp = ACT + (long)(pm * 256 + rs * 8) * DFF + f0;
#pragma unroll
      for (int i = 0; i < 8; ++i) {
        const u32x4 a2 = *(const u32x4*)(up + (i + 2) * USTR), g2 = *(const u32x4*)(up + (i + 2) * USTR + 128);
        float res[8];
#pragma unroll
        for (int e = 0; e < 8; ++e) {
          const unsigned xa0 = a0[e >> 1], xa1 = a1[e >> 1], xa2 = a2[e >> 1], xg0 = g0[e >> 1], xg1 = g1[e >> 1], xg2 = g2[e >> 1];
          const float va0 = (e & 1) ? bfhi(xa0) : bflo(xa0), va1 = (e & 1) ? bfhi(xa1) : bflo(xa1), va2 = (e & 1) ? bfhi(xa2) : bflo(xa2);
          const float vg0 = (e & 1) ? bfhi(xg0) : bflo(xg0), vg1 = (e & 1) ? bfhi(xg1) : bflo(xg1), vg2 = (e & 1) ? bfhi(xg2) : bflo(xg2);
          const float av = va0 * wa[0][e] + va1 * wa[1][e] + va2 * wa[2][e] + ba[e];
          const float gv = vg0 * wg[0][e] + vg1 * wg[1][e] + vg2 * wg[2][e] + bg[e];
          res[e] = silu_f(av) * gv;
        }
        u32x4 w; w.x = pk2(res[0], res[1]); w.y = pk2(res[2], res[3]); w.z = pk2(res[4], res[5]); w.w = pk2(res[6], res[7]);
        *(u32x4*)(outp + (long)i * DFF) = w;
        a0 = a1; g0 = g1; a1 = a2; g1 = g2;
      }
    }
    __syncthreads();
  }
};

__device__ void mod_phase(const Params& p, float* sm, int w0) {
  const int tid = otid();
  for (int task = blockIdx.x; task < 4 * 96; task += gridDim.x) {
    const int l = task / 96, e0 = (task % 96) * 64;
    __syncthreads();
    for (int i = tid; i < 33 * 1024; i += NTHREADS) { const int bi = i >> 10, d = i & 1023; const float cv = bi < 32 ? p.c[bi * 1024 + d] : p.c_ctx[d]; sm[i] = silu_f(cv); }
    __syncthreads();
    const int kg = tid >> 6, col = tid & 63;
    float acc[33];
#pragma unroll
    for (int bi = 0; bi < 33; ++bi) acc[bi] = 0.f;
    const float* w = p.ada_w + ((long)l * 1024 + kg * 128) * 6144 + e0 + col;
    for (int d = 0; d < 128; ++d) {
      const float wv = w[(long)d * 6144];
#pragma unroll
      for (int bi = 0; bi < 33; ++bi) acc[bi] += sm[bi * 1024 + kg * 128 + d] * wv;
    }
    __syncthreads();
#pragma unroll
    for (int bi = 0; bi < 33; ++bi) sm[(kg * 33 + bi) * 64 + col] = acc[bi];
    __syncthreads();
    for (int i = tid; i < 33 * 64; i += NTHREADS) {
      const int bi = i >> 6, cc = i & 63; float s = p.ada_b[l * 6144 + e0 + cc];
#pragma unroll
      for (int k = 0; k < 8; ++k) s += sm[(k * 33 + bi) * 64 + cc];
      p.mod[((long)l * 33 + bi) * 6144 + e0 + cc] = s;
    }
  }
  __syncthreads();
}

__device__ __forceinline__ void sincos_d(double ang, float& c, float& s) {
  const double TWO_PI = 6.283185307179586476925;
  const double n = rint(ang / TWO_PI); const double r = ang - n * TWO_PI, r2 = r * r;
  double tc = 1.0, sc = 1.0, ts = r, ss = r;
  for (int k = 1; k <= 16; ++k) { tc *= -r2 / (double)((2 * k - 1) * (2 * k)); sc += tc; ts *= -r2 / (double)((2 * k) * (2 * k + 1)); ss += ts; }
  c = (float)sc; s = (float)ss;
}
__device__ void table_phase(const Params& p, int w0) {
  const int g = blockIdx.x * NTHREADS + otid();
  if (g < 2048 * 8) {
    const int t = g >> 3, i = g & 7; float c, s;
    sincos_d((double)(t >> 6) * p.ax_inv[i], c, s); p.ropetab[t * 32 + i] = c; p.ropetab[t * 32 + 8 + i] = s;
    sincos_d((double)(t & 63) * p.ax_inv[i], c, s); p.ropetab[t * 32 + 16 + i] = c; p.ropetab[t * 32 + 24 + i] = s;
    sincos_d((double)t * p.ret_inv[i], c, s); p.rettab[t * 32 + i] = c; p.rettab[t * 32 + 16 + i] = s;
    sincos_d((double)t * p.ret_inv[i + 8], c, s); p.rettab[t * 32 + 8 + i] = c; p.rettab[t * 32 + 24 + i] = s;
  }
}

__device__ void convert_phase(const Params& p, int l, int tbeg, int tend, float* sm, int w0) {
  const int tid = otid();
  constexpr int T0 = 512, T1 = T0 + 48, T2 = T1 + 32, T3 = T2 + 32, T4 = T3 + 256, T5 = T4 + 1408, T6 = T5 + 704;
  for (int task = tbeg + blockIdx.x; task < tend; task += gridDim.x) {
    const float* src; bf16_t* dst; int K, N, Kp, nkt, tt; const float* ksc = nullptr; int mode = 0;
    if (task < T0)      { tt = task;      src = p.w_in + (long)l * 1024 * 1984; dst = p.Wt_in; K = 1024; N = 1984; Kp = 1024; nkt = 16; }
    else if (task < T1) { tt = task - T0; src = p.w_uq + (long)l * 256 * 768; dst = p.Wt_uq; K = 256; N = 768; Kp = 256; nkt = 4; ksc = p.qn_g + l * 256; }
    else if (task < T2) { tt = task - T1; src = p.w_uk + (long)l * 128 * 512; dst = p.Wt_uk; K = 128; N = 512; Kp = 256; nkt = 4; ksc = p.kvn_g + l * 128; }
    else if (task < T3) { tt = task - T2; src = p.w_uv + (long)l * 128 * 512; dst = p.Wt_uv; K = 128; N = 512; Kp = 256; nkt = 4; ksc = p.kvn_g + l * 128; }
    else if (task < T4) { tt = task - T3; src = p.w_out + (long)l * 1024 * 1024; dst = p.Wt_out; K = 1024; N = 1024; Kp = 1024; nkt = 16; }
    else if (task < T5) { tt = task - T4; src = p.ffn_up + (long)l * 1024 * 5632; dst = p.Wt_up; K = 1024; N = 5632; Kp = 1024; nkt = 16; mode = 1; }
    else                { tt = task - T5; src = p.ffn_down + (long)l * 2816 * 1024; dst = p.Wt_down; K = 2816; N = 1024; Kp = 2816; nkt = 44; }
    const int n0 = (tt / nkt) * 64, k0 = (tt % nkt) * 64;
    int c0 = n0;
    if (mode == 1) { const int pn = n0 >> 8, j = n0 & 255; c0 = j < 128 ? pn * 128 + j : 2816 + pn * 128 + (j - 128); }
    __syncthreads();
#pragma unroll
    for (int i = 0; i < 8; ++i) {
      const int kk = (tid >> 6) + 8 * i, nn = tid & 63; float v = 0.f;
      if (k0 + kk < K && n0 + nn < N) { v = src[(long)(k0 + kk) * N + c0 + nn]; if (ksc) v *= ksc[k0 + kk]; }
      sm[kk * 65 + nn] = v;
    }
    __syncthreads();
    { const int nn = tid >> 3, kk0 = (tid & 7) * 8; u32x4 w;
      w.x = pk2(sm[(kk0 + 0) * 65 + nn], sm[(kk0 + 1) * 65 + nn]); w.y = pk2(sm[(kk0 + 2) * 65 + nn], sm[(kk0 + 3) * 65 + nn]);
      w.z = pk2(sm[(kk0 + 4) * 65 + nn], sm[(kk0 + 5) * 65 + nn]); w.w = pk2(sm[(kk0 + 6) * 65 + nn], sm[(kk0 + 7) * 65 + nn]);
      *(u32x4*)(dst + (long)(n0 + nn) * Kp + k0 + kk0) = w; }
  }
  __syncthreads();
}

__device__ void ln_phase(const Params& p, int mode, int l, int w0) {
  const int tid = otid(); const int lane = tid & 63, wv = tid >> 6;
  const bool fin = (mode == 2 && l == 3);
  const int nrows = (mode == 0 || (mode == 2 && l < 3) || (mode == 1 && l < 3)) ? MTOT : NLAT;
  const float* lg = mode == 1 ? p.ln1_g + l * 1024 : p.ln2_g + l * 1024;
  const float* lb = mode == 1 ? p.ln1_b + l * 1024 : p.ln2_b + l * 1024;
  const int ml = mode == 0 ? 0 : (mode == 1 ? l : l + 1);
  const int shoff = mode == 1 ? 3072 : 0, scoff = mode == 1 ? 4096 : 1024;
  for (int rb = blockIdx.x * 16 + wv * 2; rb < nrows; rb += gridDim.x * 16) {
    f32x4 v[2][4];
#pragma unroll
    for (int u = 0; u < 2; ++u) {
      const int r = rb + u;
      const float* src = mode == 0 ? (r < NLAT ? p.x + (long)r * 1024 : p.ctx + (long)(r - NLAT) * 1024) : p.X + (long)r * 1024;
#pragma unroll
      for (int i = 0; i < 4; ++i) v[u][i] = __builtin_nontemporal_load((const f32x4*)(src + i * 256 + lane * 4));
    }
#pragma unroll
    for (int u = 0; u < 2; ++u) {
      const int r = rb + u;
      if (mode == 0) {
#pragma unroll
        for (int i = 0; i < 4; ++i) *(f32x4*)(p.X + (long)r * 1024 + i * 256 + lane * 4) = v[u][i];
      } else {
        float s = 0.f;
#pragma unroll
        for (int i = 0; i < 4; ++i) s += (v[u][i][0] + v[u][i][1]) + (v[u][i][2] + v[u][i][3]);
#pragma unroll
        for (int o = 32; o > 0; o >>= 1) s += __shfl_xor(s, o);
        const float mu = s * (1.f / 1024.f); float q = 0.f;
#pragma unroll
        for (int i = 0; i < 4; ++i) { v[u][i] = v[u][i] - mu; q += (v[u][i][0] * v[u][i][0] + v[u][i][1] * v[u][i][1]) + (v[u][i][2] * v[u][i][2] + v[u][i][3] * v[u][i][3]); }
#pragma unroll
        for (int o = 32; o > 0; o >>= 1) q += __shfl_xor(q, o);
        const float rs = rsqrtf(q * (1.f / 1024.f) + EPS);
        if (lane == 0 && !fin) { p.lnst[2 * r] = mu; p.lnst[2 * r + 1] = rs; }
#pragma unroll
        for (int i = 0; i < 4; ++i) { const f32x4 g = *(const f32x4*)(lg + i * 256 + lane * 4), bb = *(const f32x4*)(lb + i * 256 + lane * 4); v[u][i] = v[u][i] * rs * g + bb; }
      }
      if (fin) {
#pragma unroll
        for (int i = 0; i < 4; ++i) *(f32x4*)(p.out + (long)r * 1024 + i * 256 + lane * 4) = v[u][i];
      } else {
        const float* mb = p.mod + ((long)ml * 33 + row_bi(r)) * 6144;
#pragma unroll
        for (int i = 0; i < 4; ++i) {
          const f32x4 sh = *(const f32x4*)(mb + shoff + i * 256 + lane * 4), sc = *(const f32x4*)(mb + scoff + i * 256 + lane * 4);
          const f32x4 h = v[u][i] * (sc + 1.f) + sh;
          u32x2 w; w.x = pk2(h[0], h[1]); w.y = pk2(h[2], h[3]);
          *(u32x2*)(p.H + (long)r * 1024 + i * 256 + lane * 4) = w;
          if (mode == 1 && ((r & 255) == 0 || (r & 255) == 255)) *(u32x2*)(p.HA + (long)((r >> 8) * 2 + ((r & 255) == 255)) * 1024 + i * 256 + lane * 4) = w;
        }
      }
    }
  }
}

__device__ void mlaprep_phase(const Params& p, int w0) {
  const int tid = otid(); const int lane = tid & 63, wv = tid >> 6;
  for (int r = blockIdx.x * 8 + wv; r < MTOT; r += gridDim.x * 8) {
    const bf16_t* pr = p.P + (long)r * DIN;
    const u32x2 cq = *(const u32x2*)(pr + MCQ + lane * 4);
    const unsigned ck = *(const unsigned*)(pr + MCKV + lane * 2);
    float sq = bflo(cq.x) * bflo(cq.x) + bfhi(cq.x) * bfhi(cq.x) + bflo(cq.y) * bflo(cq.y) + bfhi(cq.y) * bfhi(cq.y);
    float sk = bflo(ck) * bflo(ck) + bfhi(ck) * bfhi(ck);
#pragma unroll
    for (int o = 32; o > 0; o >>= 1) { sq += __shfl_xor(sq, o); sk += __shfl_xor(sk, o); }
    if (lane == 0) { p.rstd[2 * r] = rsqrtf(sq * (1.f / 256.f) + EPS); p.rstd[2 * r + 1] = rsqrtf(sk * (1.f / 128.f) + EPS); }
    const float kv = bf2f(pr[MKR + (lane & 31)]);
    float outv = kv; int b, key;
    if (r < NLAT) {
      b = r >> 11; key = r & 2047;
      const float other = __shfl_xor(kv, 8);
      const int i = lane & 7, part = (lane >> 4) & 1;
      const float cs = p.ropetab[key * 32 + part * 16 + i], sn = p.ropetab[key * 32 + part * 16 + 8 + i];
      outv = (lane & 8) ? (other * sn + kv * cs) : (kv * cs - other * sn);
    } else { b = (r - NLAT) >> 8; key = 2048 + ((r - NLAT) & 255); }
    if (lane < 32) p.Kr[((long)b * 2304 + key) * 32 + lane] = f2bf(outv);
  }
}

constexpr int SSTR = 72;
__device__ __forceinline__ int chunk_row0(int b, int c) { return c < 4 ? NLAT + b * 256 + c * 64 : b * 2048 + (c - 4) * 64; }
__device__ __forceinline__ f32x4 mma16(const bf16_t* A, const bf16_t* B, f32x4 acc, int fr, int fq) {
  const bf16x8 a = *(const bf16x8*)(A + fr * SSTR + fq * 8), b = *(const bf16x8*)(B + fr * SSTR + fq * 8);
  return __builtin_amdgcn_mfma_f32_16x16x32_bf16(a, b, acc, 0, 0, 0);
}

__device__ __forceinline__ long state_idx(int mx, int b, int h, int dir, int c) { return ((((long)(mx * 32 + b) * 4 + h) * 2 + dir) * 36 + c); }

struct ScanPre { u32x2 kw, qw, kp, qp, lw; u32x4 vw, gw; f32x4 cs, sn; float w[16]; float bias; u32x4 st; };

template <bool C>
__device__ __forceinline__ void scan_fetch(const Params& p, int l, int task, int tid, ScanPre& R) {
  const int c = task % 36, h = (task / 36) & 3, b = (task / 144) & 31, mx = task / 4608;
  const int row0 = chunk_row0(b, c);
  const int qoff = (mx ? RQ : GQ) + h * 32, koff = (mx ? RK : GK) + h * 32, voff = (mx ? RV : GV) + h * 64;
  const int s = tid >> 3, d0 = (tid & 7) * 4;
  const bf16_t* pr = p.P + (long)(row0 + s) * DIN;
  R.kw = *(const u32x2*)(pr + koff + d0);
  if (C) R.qw = *(const u32x2*)(pr + qoff + d0);
  if (mx == 1 && c >= 4) {
    const int dp = d0 ^ 16, i0 = d0 & 15, t = (c - 4) * 64 + s;
    R.kp = *(const u32x2*)(pr + koff + dp);
    if (C) R.qp = *(const u32x2*)(pr + qoff + dp);
    R.cs = *(const f32x4*)(p.rettab + t * 32 + i0); R.sn = *(const f32x4*)(p.rettab + t * 32 + 16 + i0);
  }
  R.vw = *(const u32x4*)(pr + voff + (tid & 7) * 8);
  const int gd = tid & 31, gdir = (tid >> 5) & 1;
  if (mx == 0) {
    R.lw = *(const u32x2*)(pr + GLR + d0);
#pragma unroll
    for (int r = 0; r < 16; ++r) R.w[r] = p.gate_w[(((long)l * 2 + gdir) * 16 + r) * 128 + h * 32 + gd];
    R.bias = p.gate_b[((long)l * 2 + gdir) * 128 + h * 32 + gd];
  } else R.bias = p.ret_decay[((long)l * 2 + gdir) * 4 + h];
  if (C) {
    R.gw = *(const u32x4*)(pr + (mx ? RG : GG) + h * 64 + (tid & 7) * 8);
    R.st = *(const u32x4*)(p.St + state_idx(mx, b, h, tid >> 8, c) * 2048 + (tid & 255) * 8);
  }
}

template <bool C>
__device__ __forceinline__ void scan_stage1(const ScanPre& R, int mx, int c, int tid, float* lrs, bf16_t* VT, float (&kv)[4], float (&qv)[4]) {
  const int s = tid >> 3, d0 = (tid & 7) * 4;
  kv[0] = bflo(R.kw.x); kv[1] = bfhi(R.kw.x); kv[2] = bflo(R.kw.y); kv[3] = bfhi(R.kw.y);
  qv[0] = qv[1] = qv[2] = qv[3] = 0.f;
  if (C) { qv[0] = bflo(R.qw.x); qv[1] = bfhi(R.qw.x); qv[2] = bflo(R.qw.y); qv[3] = bfhi(R.qw.y); }
  if (mx == 1 && c >= 4) {
    const float kpv[4] = {bflo(R.kp.x), bfhi(R.kp.x), bflo(R.kp.y), bfhi(R.kp.y)};
    float qpv[4] = {0.f, 0.f, 0.f, 0.f};
    if (C) { qpv[0] = bflo(R.qp.x); qpv[1] = bfhi(R.qp.x); qpv[2] = bflo(R.qp.y); qpv[3] = bfhi(R.qp.y); }
#pragma unroll
    for (int j = 0; j < 4; ++j) {
      const float cs = R.cs[j], sn = R.sn[j];
      if (d0 < 16) { kv[j] = kv[j] * cs - kpv[j] * sn; qv[j] = qv[j] * cs - qpv[j] * sn; }
      else         { kv[j] = kpv[j] * sn + kv[j] * cs; qv[j] = qpv[j] * sn + qv[j] * cs; }
    }
  }
  const int e0 = (tid & 7) * 8;
#pragma unroll
  for (int j = 0; j < 4; ++j) { VT[(e0 + 2 * j) * SSTR + s] = (bf16_t)(R.vw[j] & 0xffffu); VT[(e0 + 2 * j + 1) * SSTR + s] = (bf16_t)(R.vw[j] >> 16); }
  if (mx == 0) { *(f32x4*)(lrs + s * 32 + d0) = (f32x4){bflo(R.lw.x), bfhi(R.lw.x), bflo(R.lw.y), bfhi(R.lw.y)}; }
}

__device__ __forceinline__ void scan_stage2(const ScanPre& R, int mx, int tid, const float* lrs, float* tot, float (&a)[8]) {
  const int d = tid & 31, dir = (tid >> 5) & 1, sg = tid >> 6;
  if (mx == 0) {
#pragma unroll
    for (int j = 0; j < 8; ++j) {
      float z = R.bias;
#pragma unroll
      for (int r = 0; r < 16; r += 4) { const f32x4 lv = *(const f32x4*)(lrs + (sg * 8 + j) * 32 + dir * 16 + r); z += lv[0] * R.w[r] + lv[1] * R.w[r + 1] + lv[2] * R.w[r + 2] + lv[3] * R.w[r + 3]; }
      a[j] = logsigmoid_f(z) * (1.f / 16.f);
    }
  } else {
    const float lg = logsigmoid_f(R.bias);
#pragma unroll
    for (int j = 0; j < 8; ++j) a[j] = lg;
  }
  if (dir == 0) {
#pragma unroll
    for (int j = 1; j < 8; ++j) a[j] += a[j - 1];
  } else {
#pragma unroll
    for (int j = 6; j >= 0; --j) a[j] += a[j + 1];
  }
  tot[sg * 64 + dir * 32 + d] = dir == 0 ? a[7] : a[0];
}
__device__ __forceinline__ void scan_stage3(int tid, const float* tot, float* bc, const float (&a)[8]) {
  const int d = tid & 31, dir = (tid >> 5) & 1, sg = tid >> 6;
  float off = 0.f;
#pragma unroll
  for (int g = 0; g < 8; ++g) { const float tv = tot[g * 64 + dir * 32 + d]; if (dir == 0 ? (g < sg) : (g > sg)) off += tv; }
#pragma unroll
  for (int j = 0; j < 8; ++j) bc[(dir * 64 + sg * 8 + j) * 32 + d] = a[j] + off;
}

__device__ void scanA_phase(const Params& p, int l, char* shm, int w0) {
  float* bc = (float*)shm; float* lrs = bc + 4096; float* tot = lrs + 2048;
  bf16_t* VT = (bf16_t*)(tot + 512); bf16_t* KHT = VT + 64 * SSTR;
  const int tid = otid(), wv = tid >> 6, lane = tid & 63, fr = lane & 15, fq = lane >> 4;
  const int NT = 2 * 32 * 4 * 36;
  ScanPre R;
  int task = blockIdx.x;
  if (task < NT) scan_fetch<false>(p, l, task, tid, R);
  for (; task < NT; task += gridDim.x) {
    const int c = task % 36, h = (task / 36) & 3, b = (task / 144) & 31, mx = task / 4608;
    float kv[4], qv[4], a[8];
    __syncthreads();
    scan_stage1<false>(R, mx, c, tid, lrs, VT, kv, qv);
    __syncthreads();
    scan_stage2(R, mx, tid, lrs, tot, a);
    if (task + (int)gridDim.x < NT) scan_fetch<false>(p, l, task + gridDim.x, tid, R);
    __syncthreads();
    scan_stage3(tid, tot, bc, a);
    __syncthreads();
    { const int s = tid >> 3, d0 = (tid & 7) * 4;
#pragma unroll
      for (int dir = 0; dir < 2; ++dir) {
        const f32x4 bv = *(const f32x4*)(bc + (dir * 64 + s) * 32 + d0), be = *(const f32x4*)(bc + (dir * 64 + (dir ? 0 : 63)) * 32 + d0);
#pragma unroll
        for (int j = 0; j < 4; ++j) KHT[(dir * 32 + d0 + j) * SSTR + s] = f2bf(kv[j] * __expf(be[j] - bv[j]));
      }
      if (tid < 64) { const int d = tid & 31, dir = tid >> 5; p.dec[state_idx(mx, b, h, dir, c) * 32 + d] = __expf(bc[(dir * 64 + (dir ? 0 : 63)) * 32 + d]); }
    }
    __syncthreads();
#pragma unroll
    for (int q = 0; q < 2; ++q) {
      const int id = wv * 2 + q, dir = id >> 3, dti = (id >> 2) & 1, eti = id & 3;
      f32x4 acc = {0.f, 0.f, 0.f, 0.f};
#pragma unroll
      for (int ks = 0; ks < 2; ++ks) acc = mma16(KHT + (dir * 32 + dti * 16) * SSTR + ks * 32, VT + (eti * 16) * SSTR + ks * 32, acc, fr, fq);
      asm volatile("s_nop 15\n\ts_nop 15" : "+v"(acc[0]), "+v"(acc[1]), "+v"(acc[2]), "+v"(acc[3]));
      u32x2 wst; wst.x = pk2(acc[0], acc[1]); wst.y = pk2(acc[2], acc[3]);
      *(u32x2*)(p.St + state_idx(mx, b, h, dir, c) * 2048 + (eti * 16 + fr) * 32 + dti * 16 + fq * 4) = wst;
    }
  }
  __syncthreads();
}

__device__ void scanB_phase(const Params& p, int w0) {
  const int tid = otid();
  for (int task = blockIdx.x; task < 512 * 2; task += gridDim.x) {
    const int chain = task >> 1, i = ((task & 1) * 512 + tid) * 2, d = i & 31, dir = chain & 1;
    bf16_t* st = p.St + (long)chain * 36 * 2048 + i; const float* dc = p.dec + (long)chain * 36 * 32 + d;
    unsigned loc[36]; float dv0[36], dv1[36];
#pragma unroll
    for (int k = 0; k < 36; ++k) { const int c = dir == 0 ? k : (k < 4 ? 3 - k : 39 - k); loc[k] = *(const unsigned*)(st + (long)c * 2048); dv0[k] = dc[c * 32]; dv1[k] = dc[c * 32 + 1]; }
    float r0 = 0.f, r1 = 0.f;
#pragma unroll
    for (int k = 0; k < 36; ++k) { const int c = dir == 0 ? k : (k < 4 ? 3 - k : 39 - k); *(unsigned*)(st + (long)c * 2048) = pk2(r0, r1); r0 = r0 * dv0[k] + bflo(loc[k]); r1 = r1 * dv1[k] + bfhi(loc[k]); }
  }
}

__device__ void scanC_phase(const Params& p, int l, bool last, char* shm, int w0) {
  float* bc = (float*)shm; float* lrs = bc + 4096; float* tot = lrs + 2048;
  bf16_t* VT = (bf16_t*)(tot + 512); bf16_t* QFB = VT + 64 * SSTR; bf16_t* KFB = QFB + 64 * SSTR; bf16_t* ST = KFB + 64 * SSTR; bf16_t* ATT = ST + 64 * SSTR;
  float* O = (float*)(ATT + 64 * SSTR);
  const int tid = otid(), wv = tid >> 6, lane = tid & 63, fr = lane & 15, fq = lane >> 4;
  const float qscale = 0.17677669529663687f;
  const int NT = 2 * 32 * 4 * 36, G = gridDim.x;
  auto nextt = [&](int t) { t += G; while (last && t < NT && (t % 36) < 4) t += G; return t; };
  ScanPre R;
  int task = (int)blockIdx.x - G; task = nextt(task);
  if (task < NT) scan_fetch<true>(p, l, task, tid, R);
  for (; task < NT;) {
    const int c = task % 36, h = (task / 36) & 3, b = (task / 144) & 31, mx = task / 4608;
    const int ntask = nextt(task);
    float kv[4], qv[4], a[8];
    __syncthreads();
    scan_stage1<true>(R, mx, c, tid, lrs, VT, kv, qv);
    { const int idx = (tid & 255) * 8; *(u32x4*)(ST + (idx >> 5) * SSTR + (tid >> 8) * 32 + (idx & 31)) = R.st; }
    const u32x4 gw = R.gw;
    __syncthreads();
    scan_stage2(R, mx, tid, lrs, tot, a);
    if (ntask < NT) scan_fetch<true>(p, l, ntask, tid, R);
    __syncthreads();
    scan_stage3(tid, tot, bc, a);
    __syncthreads();
    { const int s = tid >> 3, d0 = (tid & 7) * 4;
#pragma unroll
      for (int dir = 0; dir < 2; ++dir) {
        const f32x4 bv = *(const f32x4*)(bc + (dir * 64 + s) * 32 + d0);
        float qx[4], kx[4];
#pragma unroll
        for (int j = 0; j < 4; ++j) { qx[j] = qv[j] * qscale * __expf(bv[j]); kx[j] = kv[j] * __expf(-bv[j]); }
        u32x2 wq, wk; wq.x = pk2(qx[0], qx[1]); wq.y = pk2(qx[2], qx[3]); wk.x = pk2(kx[0], kx[1]); wk.y = pk2(kx[2], kx[3]);
        *(u32x2*)(QFB + s * SSTR + dir * 32 + d0) = wq; *(u32x2*)(KFB + s * SSTR + dir * 32 + d0) = wk;
      }
    }
    __syncthreads();
#pragma unroll
    for (int q = 0; q < 2; ++q) {
      const int id = wv * 2 + q, tt = id >> 2, ts = id & 3;
      f32x4 af = {0.f, 0.f, 0.f, 0.f}, ab = {0.f, 0.f, 0.f, 0.f};
      if (ts <= tt) af = mma16(QFB + tt * 16 * SSTR, KFB + ts * 16 * SSTR, af, fr, fq);
      if (ts >= tt) ab = mma16(QFB + tt * 16 * SSTR + 32, KFB + ts * 16 * SSTR + 32, ab, fr, fq);
#pragma unroll
      for (int j = 0; j < 4; ++j) {
        const int t = tt * 16 + fq * 4 + j, s = ts * 16 + fr;
        const float v = (s <= t ? af[j] : 0.f) + (s >= t ? ab[j] : 0.f);
        ATT[t * SSTR + s] = f2bf(v);
      }
    }
    __syncthreads();
#pragma unroll
    for (int q = 0; q < 2; ++q) {
      const int id = wv * 2 + q, tt = id >> 2, et = id & 3;
      f32x4 acc = {0.f, 0.f, 0.f, 0.f};
#pragma unroll
      for (int ks = 0; ks < 2; ++ks) {
        acc = mma16(ATT + tt * 16 * SSTR + ks * 32, VT + et * 16 * SSTR + ks * 32, acc, fr, fq);
        acc = mma16(QFB + tt * 16 * SSTR + ks * 32, ST + et * 16 * SSTR + ks * 32, acc, fr, fq);
      }
#pragma unroll
      for (int j = 0; j < 4; ++j) O[(tt * 16 + fq * 4 + j) * 65 + et * 16 + fr] = acc[j];
    }
    __syncthreads();
    { const int t = tid >> 3, e0 = (tid & 7) * 8; float o[8]; float s = 0.f;
#pragma unroll
      for (int j = 0; j < 8; ++j) { o[j] = O[t * 65 + e0 + j]; s += o[j]; }
      s += __shfl_xor(s, 1); s += __shfl_xor(s, 2); s += __shfl_xor(s, 4);
      const float mu = mx == 1 ? s * (1.f / 64.f) : 0.f; float qq = 0.f;
#pragma unroll
      for (int j = 0; j < 8; ++j) { o[j] -= mu; qq += o[j] * o[j]; }
      qq += __shfl_xor(qq, 1); qq += __shfl_xor(qq, 2); qq += __shfl_xor(qq, 4);
      const float rs = rsqrtf(qq * (1.f / 64.f) + EPS);
      const int row = chunk_row0(b, c) + t;
      float r[8];
#pragma unroll
      for (int j = 0; j < 8; ++j) {
        const unsigned w = gw[j >> 1]; const float gt = (j & 1) ? bfhi(w) : bflo(w);
        float y = o[j] * rs; if (mx == 0) y *= p.gla_g[l * 64 + e0 + j];
        r[j] = y * silu_f(gt);
      }
      u32x4 w; w.x = pk2(r[0], r[1]); w.y = pk2(r[2], r[3]); w.z = pk2(r[4], r[5]); w.w = pk2(r[6], r[7]);
      *(u32x4*)(p.H + (long)row * 1024 + mx * 256 + h * 64 + e0) = w;
    }
    task = ntask;
  }
  __syncthreads();
}

constexpr int KSTR = 104, VSTR = 72;
__device__ void attn_phase(const Params& p, bool last, char* shm, int w0) {
  bf16_t* Ks = (bf16_t*)shm;
  bf16_t* Vs = Ks + 2 * 64 * KSTR;
  const int tid = otid(), wv = tid >> 6, lane = tid & 63, lq = lane & 31, hb = lane >> 5;
  const int ntask = 1024 + (last ? 0 : 256);
  for (int task = blockIdx.x; task < ntask; task += gridDim.x) {
    int b, h, qrow0, nkeys, key0, nwav;
    if (task < 1024) { b = task >> 5; h = (task >> 2) & 7; qrow0 = b * 2048 + (task & 3) * 512; nkeys = 2304; key0 = 0; nwav = 8; }
    else { const int t = task - 1024; b = t >> 3; h = t & 7; qrow0 = NLAT + b * 256; nkeys = 256; key0 = 2048; nwav = 4; }
    const bool act = wv < nwav;
    bf16x8 qf[2][6];
    if (act) {
#pragma unroll
      for (int qt = 0; qt < 2; ++qt) {
        const int row = qrow0 + wv * 64 + qt * 32 + lq; const bf16_t* qp = p.Q + (long)row * 768 + h * 96;
#pragma unroll
        for (int ks = 0; ks < 4; ++ks) qf[qt][ks] = *(const bf16x8*)(qp + ks * 16 + hb * 8);
#pragma unroll
        for (int ks = 4; ks < 6; ++ks) {
          const bf16x8 own = *(const bf16x8*)(qp + ks * 16 + hb * 8);
          if (task < 1024) {
            const bf16x8 oth = *(const bf16x8*)(qp + ks * 16 + (hb ^ 1) * 8);
            const int t = row & 2047; const float* tb = p.ropetab + t * 32 + (ks - 4) * 16;
            bf16x8 r;
#pragma unroll
            for (int i = 0; i < 8; i += 2) {
              const float cs0 = tb[i], sn0 = tb[8 + i], cs1 = tb[i + 1], sn1 = tb[9 + i];
              const float o0 = bf2f((bf16_t)own[i]), o1 = bf2f((bf16_t)own[i + 1]), x0 = bf2f((bf16_t)oth[i]), x1 = bf2f((bf16_t)oth[i + 1]);
              const float r0 = hb ? (x0 * sn0 + o0 * cs0) : (o0 * cs0 - x0 * sn0);
              const float r1 = hb ? (x1 * sn1 + o1 * cs1) : (o1 * cs1 - x1 * sn1);
              const unsigned w = pk2(r0, r1); r[i] = (short)(w & 0xffffu); r[i + 1] = (short)(w >> 16);
            }
            qf[qt][ks] = r;
          } else qf[qt][ks] = own;
        }
      }
    }
    f32x16 ot[2][2];
#pragma unroll
    for (int i = 0; i < 2; ++i)
#pragma unroll
      for (int j = 0; j < 2; ++j)
#pragma unroll
        for (int e = 0; e < 16; ++e) ot[i][j][e] = 0.f;
    float mrun[2] = {0.f, 0.f}, lrun[2] = {0.f, 0.f};
    const bf16_t* Kng = p.Kn + ((long)(b * 8 + h) * 2304 + key0) * 64;
    const bf16_t* Krg = p.Kr + ((long)b * 2304 + key0) * 32;
    const bf16_t* Vtg = p.Vt + ((long)(b * 8 + h) * 64) * 2304 + key0;
    const unsigned offk = (unsigned)tid * 16u, offr = (unsigned)(tid & 255) * 16u, offv = (unsigned)((tid >> 3) * 2304 + (tid & 7) * 8) * 2u;
    const int lk0 = (tid >> 3) * KSTR + (tid & 7) * 8, lk1 = ((tid & 255) >> 2) * KSTR + 64 + (tid & 3) * 8, lv = (tid >> 3) * VSTR + (tid & 7) * 8;
    u32x4 rk0, rk1 = {0, 0, 0, 0}, rv;
    auto gload = [&](int kt) {
      rk0 = *(const u32x4*)((const char*)Kng + (size_t)kt * 8192 + offk);
      if (tid < 256) rk1 = *(const u32x4*)((const char*)Krg + (size_t)kt * 4096 + offr);
      rv = *(const u32x4*)((const char*)Vtg + (size_t)kt * 128 + offv);
    };
    auto lstore = [&](int buf) {
      *(u32x4*)(Ks + buf * 64 * KSTR + lk0) = rk0;
      if (tid < 256) *(u32x4*)(Ks + buf * 64 * KSTR + lk1) = rk1;
      *(u32x4*)(Vs + buf * 64 * VSTR + lv) = rv;
    };
    const int ntile = nkeys / 64;
    __syncthreads();
    gload(0); lstore(0);
    __syncthreads();
    for (int kt = 0; kt < ntile; ++kt) {
      const int buf = kt & 1;
      if (kt + 1 < ntile) gload(kt + 1);
      if (act) {
        const bf16_t* Kb = Ks + buf * 64 * KSTR; const bf16_t* Vb = Vs + buf * 64 * VSTR;
#pragma unroll
        for (int k2 = 0; k2 < 2; ++k2) {
          f32x16 st[2];
#pragma unroll
          for (int j = 0; j < 2; ++j)
#pragma unroll
            for (int e = 0; e < 16; ++e) st[j][e] = -mrun[j];
#pragma unroll
          for (int ks = 0; ks < 6; ++ks) {
            const bf16x8 kf = *(const bf16x8*)(Kb + (k2 * 32 + lq) * KSTR + ks * 16 + hb * 8);
            st[0] = __builtin_amdgcn_mfma_f32_32x32x16_bf16(kf, qf[0][ks], st[0], 0, 0, 0);
            st[1] = __builtin_amdgcn_mfma_f32_32x32x16_bf16(kf, qf[1][ks], st[1], 0, 0, 0);
          }
          bf16x8 pf[2][2];
#pragma unroll
          for (int qt = 0; qt < 2; ++qt) {
            float mx = st[qt][0];
#pragma unroll
            for (int e = 1; e < 16; ++e) mx = fmaxf(mx, st[qt][e]);
            mx = fmaxf(mx, __shfl_xor(mx, 32));
            const bool first = (kt == 0 && k2 == 0);
            if (first || __builtin_amdgcn_ballot_w64(mx > 6.f) != 0ull) {
              const float delta = first ? mx : fmaxf(mx, 0.f);
              const float alpha = first ? 1.f : __builtin_amdgcn_exp2f(-delta);
              mrun[qt] += delta;
#pragma unroll
              for (int e = 0; e < 16; ++e) st[qt][e] -= delta;
              lrun[qt] *= alpha;
#pragma unroll
              for (int dt = 0; dt < 2; ++dt)
#pragma unroll
                for (int e = 0; e < 16; ++e) ot[dt][qt][e] *= alpha;
            }
            float ls = 0.f;
#pragma unroll
            for (int s2 = 0; s2 < 2; ++s2) {
              const int g0 = s2 * 2; bf16x8 f;
#pragma unroll
              for (int j = 0; j < 4; j += 2) {
                const float p0 = __builtin_amdgcn_exp2f(st[qt][g0 * 4 + j]), p1 = __builtin_amdgcn_exp2f(st[qt][g0 * 4 + j + 1]);
                const float p2 = __builtin_amdgcn_exp2f(st[qt][(g0 + 1) * 4 + j]), p3 = __builtin_amdgcn_exp2f(st[qt][(g0 + 1) * 4 + j + 1]);
                ls += (p0 + p1) + (p2 + p3);
                const unsigned ww0 = pk2(p0, p1), ww1 = pk2(p2, p3);
                f[j] = (short)(ww0 & 0xffffu); f[j + 1] = (short)(ww0 >> 16); f[4 + j] = (short)(ww1 & 0xffffu); f[4 + j + 1] = (short)(ww1 >> 16);
              }
              pf[qt][s2] = f;
            }
            lrun[qt] += ls;
          }
#pragma unroll
          for (int dt = 0; dt < 2; ++dt)
#pragma unroll
            for (int s2 = 0; s2 < 2; ++s2) {
              const bf16_t* vp = Vb + (dt * 32 + lq) * VSTR + (k2 * 2 + s2) * 16 + hb * 4;
              const bf16x4 v0 = *(const bf16x4*)vp, v1 = *(const bf16x4*)(vp + 8);
              bf16x8 vf; vf[0] = v0[0]; vf[1] = v0[1]; vf[2] = v0[2]; vf[3] = v0[3]; vf[4] = v1[0]; vf[5] = v1[1]; vf[6] = v1[2]; vf[7] = v1[3];
              ot[dt][0] = __builtin_amdgcn_mfma_f32_32x32x16_bf16(vf, pf[0][s2], ot[dt][0], 0, 0, 0);
              ot[dt][1] = __builtin_amdgcn_mfma_f32_32x32x16_bf16(vf, pf[1][s2], ot[dt][1], 0, 0, 0);
            }
        }
      }
      if (kt + 1 < ntile) lstore(buf ^ 1);
      __syncthreads();
    }
    if (act) {
#pragma unroll
      for (int qt = 0; qt < 2; ++qt) {
        const float lt = lrun[qt] + __shfl_xor(lrun[qt], 32); const float inv = 1.f / lt;
        const int row = qrow0 + wv * 64 + qt * 32 + lq; bf16_t* op = p.H + (long)row * 1024 + 512 + h * 64;
#pragma unroll
        for (int dt = 0; dt < 2; ++dt)
#pragma unroll
          for (int g = 0; g < 4; ++g) {
            u32x2 w; w.x = pk2(ot[dt][qt][g * 4] * inv, ot[dt][qt][g * 4 + 1] * inv); w.y = pk2(ot[dt][qt][g * 4 + 2] * inv, ot[dt][qt][g * 4 + 3] * inv);
            *(u32x2*)(op + dt * 32 + g * 8 + hb * 4) = w;
          }
      }
    }
  }
  __syncthreads();
}

#define XB_TMO      128
#define XB_XCNT(j)  (256  + 64 * (j))
#define XB_XSUB(j)  (1280 + 64 * (j))
#define XB_XGEN(j)  (2304 + 64 * (j))
#define XB_TOP      3328
#define XB_TOPGEN   3392
#define XCD_BAR_WORDS 3456
#define XB_SPIN_CAP (1u << 18)
#define LAS __attribute__((address_space(3)))
__device__ __forceinline__ unsigned xb_ld(unsigned* p)              { return __hip_atomic_load(p, __ATOMIC_RELAXED, __HIP_MEMORY_SCOPE_AGENT); }
__device__ __forceinline__ unsigned xb_add(unsigned* p, unsigned v) { return __hip_atomic_fetch_add(p, v, __ATOMIC_RELAXED, __HIP_MEMORY_SCOPE_AGENT); }
__device__ __forceinline__ unsigned xb_xcc_id() { return (unsigned)__builtin_amdgcn_s_getreg((3 << 11) | 20) & 0xFu; }
#define XB_SPIN(cond, bar) do { unsigned _sp = 0; while (cond) { __builtin_amdgcn_s_sleep(1); \
    if ((++_sp & 255u) == 0u) { if (xb_ld(&(bar)[XB_TMO])) break; if (_sp > XB_SPIN_CAP) { atomicAdd(&(bar)[XB_TMO], 1u); break; } } } } while (0)
struct XcdBarrier { unsigned* bar; unsigned x; volatile LAS unsigned* st; };
__device__ __forceinline__ XcdBarrier xcd_barrier_post(unsigned* bar, volatile LAS unsigned* st, int tid) {
  XcdBarrier b; b.bar = bar; b.x = xb_xcc_id(); b.st = st;
  if (tid == 0) (void)xb_add(&bar[XB_XCNT(b.x)], 1u);
  return b;
}
__device__ __forceinline__ void xcd_barrier_complete(unsigned* bar, unsigned x, unsigned& nloc, unsigned& nx) {
  const unsigned G = gridDim.x * gridDim.y * gridDim.z;
  unsigned sum, cnt, mine, sp = 0u;
  for (;;) {
    sum = 0u; cnt = 0u; mine = 0u;
#pragma unroll
    for (unsigned j = 0; j < 16; ++j) { const unsigned c = xb_ld(&bar[XB_XCNT(j)]); sum += c; cnt += (c > 0u) ? 1u : 0u; mine = (j == x) ? c : mine; }
    if (sum == G) break;
    __builtin_amdgcn_s_sleep(1);
    if ((++sp & 255u) == 0u) { if (xb_ld(&bar[XB_TMO])) break; if (sp > XB_SPIN_CAP) { atomicAdd(&bar[XB_TMO], 1u); break; } }
  }
  nloc = mine > 0u ? mine : 1u; nx = cnt > 0u ? cnt : 1u;
}
__device__ __forceinline__ void xcd_barrier(unsigned* bar_, volatile LAS unsigned* st_, int tid) {
  XcdBarrier b; b.bar = bar_; b.st = st_; b.x = xb_xcc_id();
  asm volatile("s_waitcnt vmcnt(0)" ::: "memory");
  __syncthreads();
  if (tid == 0) {
    unsigned* bar = b.bar;
    __builtin_amdgcn_s_waitcnt(0);
    unsigned nloc = b.st[0], nx = b.st[1];
    if (nloc == 0u) { xcd_barrier_complete(bar, b.x, nloc, nx); b.st[0] = nloc; b.st[1] = nx; }
    const unsigned old = xb_add(&bar[XB_XSUB(b.x)], 1u);
    const unsigned gen = old / nloc;
    if (old + 1u == (gen + 1u) * nloc) {
      __builtin_amdgcn_fence(__ATOMIC_RELEASE, "agent");
      asm volatile("s_waitcnt vmcnt(0)" ::: "memory");
      const unsigned og = xb_add(&bar[XB_TOP], 1u);
      const unsigned tg = og / nx;
      if (og + 1u == (tg + 1u) * nx) xb_add(&bar[XB_TOPGEN], 1u);
      else XB_SPIN(xb_ld(&bar[XB_TOPGEN]) == tg, bar);
      __builtin_amdgcn_fence(__ATOMIC_ACQUIRE, "agent");
      xb_add(&bar[XB_XGEN(b.x)], 1u);
      asm volatile("s_waitcnt vmcnt(0)" ::: "memory");
    } else {
      XB_SPIN(xb_ld(&bar[XB_XGEN(b.x)]) == gen, bar);
      __builtin_amdgcn_fence(__ATOMIC_ACQUIRE, "agent");
      asm volatile("s_waitcnt vmcnt(0)" ::: "memory");
    }
  }
  __syncthreads();
}

__device__ void run_phase(const Params& p, int ph, char* shm, int w0) {
  if (ph == 0) { mod_phase(p, (float*)shm, w0); table_phase(p, w0); convert_phase(p, 0, 0, 2992, (float*)shm, w0); return; }
  if (ph == 1) { ln_phase(p, 0, 0, w0); return; }
  const int l = (ph - 2) / NPL, s = (ph - 2) % NPL; const bool last = (l == 3);
  const float* modl = p.mod + (long)l * 33 * 6144;
  bf16_t* sh = (bf16_t*)shm;
  switch (s) {
    case 0: { EpiP e{p.P}; gemm_phase<true>(p.H, 1024, p.Wt_in, 1024, MTOT / 256, 8, 1024, e, sh, w0); } break;
    case 1: scanA_phase(p, l, shm, w0); mlaprep_phase(p, w0); if (l > 0) convert_phase(p, l, 2288, 2992, (float*)shm, w0); break;
    case 2: { scanB_phase(p, w0); EpiVt e{p.Vt, p.rstd}; gemm_phase<true>(p.Wt_uv, 256, p.P + MCKV, DIN, 2, MTOT / 256, 256, e, sh, w0); } break;
    case 3: scanC_phase(p, l, last, shm, w0); break;
    case 4: { EpiQ e{p.Q, p.rstd}; gemm_phase<true>(p.P + MCQ, DIN, p.Wt_uq, 256, (last ? NLAT : MTOT) / 256, 3, 256, e, sh, w0);
              EpiK e2{p.Kn, p.rstd}; gemm_phase<true>(p.P + MCKV, DIN, p.Wt_uk, 256, MTOT / 256, 2, 256, e2, sh, w0); } break;
    case 5: attn_phase(p, last, shm, w0); break;
    case 6: { EpiResLN e{p, l, 0}; gemm_phase<true, true>(p.H, 1024, p.Wt_out, 1024, (last ? NLAT : MTOT) / 256, 4, 1024, e, sh, w0); } break;
    case 7: { EpiU e{p.HU}; gemm_phase<true>(p.HA, 1024, p.Wt_up, 1024, 3, 22, 1024, e, sh, w0);
              if (!last) convert_phase(p, l + 1, 0, 880, (float*)shm, w0); } break;
    case 8: { EpiConv e{p.ACT, p.HU, p.conv_w + (long)l * 3 * 5632, p.conv_b + (long)l * 5632}; gemm_phase<false>(p.H, 1024, p.Wt_up, 1024, (last ? NLAT : MTOT) / 256, 22, 1024, e, sh, w0); } break;
    case 9: { EpiResLN e{p, l, 1}; gemm_phase<true, true>(p.ACT, DFF, p.Wt_down, DFF, (last ? NLAT : MTOT) / 256, 4, DFF, e, sh, w0);
              if (!last) convert_phase(p, l + 1, 880, 2288, (float*)shm, w0); } break;
  }
}

__global__ void __launch_bounds__(NTHREADS) mk(Params p, int ph0, int ph1) {
  extern __shared__ __attribute__((aligned(16))) char shm[];
  __shared__ uint4 xb_words;
  cg::grid_group grid = cg::this_grid();
  const int w0 = __builtin_amdgcn_readfirstlane((int)(threadIdx.x >> 6));
  {
    const int tid = otid();
    if (tid == 0) xb_words = make_uint4(0u, 0u, 0u, 0u);
    __syncthreads();
  }
  { const int tid = otid(); (void)xcd_barrier_post(p.bar, (volatile LAS unsigned*)&xb_words, tid); }
  if (ph1 < 0) grid.sync();
  for (int ph = ph0; ph < ph1; ++ph) {
    run_phase(p, ph, shm, w0);
    if (ph + 1 < ph1) {
      { const int tid = otid(); xcd_barrier(p.bar, (volatile LAS unsigned*)&xb_words, tid); }
    }
  }
}

extern "C" void kernel_launch(void* const* d_in, const int* in_sizes, int n_in, void* d_out, int out_size, void* d_ws, size_t ws_size, hipStream_t stream) {
  static int grid_blocks = 0;
  if (!grid_blocks) {
    int dev = 0, cus = 0, per_cu = 0;
    hipGetDevice(&dev);
    hipDeviceGetAttribute(&cus, hipDeviceAttributeMultiprocessorCount, dev);
    hipFuncSetAttribute((const void*)mk, hipFuncAttributeMaxDynamicSharedMemorySize, LDS_BYTES);
    hipOccupancyMaxActiveBlocksPerMultiprocessor(&per_cu, mk, NTHREADS, LDS_BYTES);
    if (per_cu < 1) per_cu = 1;
    grid_blocks = cus * per_cu;
    (void)hipGetLastError();
  }
  Params p{};
  const float** pin = (const float**)&p.x;
  for (int i = 0; i < 25; ++i) pin[i] = (const float*)d_in[i];
  p.out = (float*)d_out;
  char* w = (char*)d_ws; size_t off = 0;
  auto take = [&](size_t bytes) { char* r = w + off; off += (bytes + 255) & ~(size_t)255; return r; };
  p.X = (float*)take((size_t)MTOT * 1024 * 4);
  p.H = (bf16_t*)take((size_t)MTOT * 1024 * 2);
  p.P = (bf16_t*)take((size_t)MTOT * DIN * 2 + 4096);
  p.ACT = p.P;
  p.Q = (bf16_t*)take((size_t)MTOT * 768 * 2);
  p.Kn = (bf16_t*)take((size_t)32 * 8 * 2304 * 64 * 2);
  p.St = p.Q;
  p.Vt = (bf16_t*)take((size_t)32 * 8 * 64 * 2304 * 2);
  p.Kr = (bf16_t*)take((size_t)32 * 2304 * 32 * 2);
  p.HA = (bf16_t*)take((size_t)768 * 1024 * 2);
  p.HU = (bf16_t*)take((size_t)768 * 5632 * 2);
  p.dec = (float*)take((size_t)512 * 36 * 32 * 4);
  p.rstd = (float*)take((size_t)MTOT * 2 * 4 + 64);
  p.lnst = (float*)take((size_t)MTOT * 2 * 4);
  p.mod = (float*)take((size_t)4 * 33 * 6144 * 4);
  p.ropetab = (float*)take(2048 * 32 * 4);
  p.rettab = (float*)take(2048 * 32 * 4);
  p.Wt_in = (bf16_t*)take((size_t)2048 * 1024 * 2);
  p.Wt_uq = (bf16_t*)take((size_t)768 * 256 * 2);
  p.Wt_uk = (bf16_t*)take((size_t)512 * 256 * 2);
  p.Wt_uv = (bf16_t*)take((size_t)512 * 256 * 2);
  p.Wt_out = (bf16_t*)take((size_t)1024 * 1024 * 2);
  p.Wt_up = (bf16_t*)take((size_t)5632 * 1024 * 2);
  p.Wt_down = (bf16_t*)take((size_t)1024 * 2816 * 2);
  p.bar = (unsigned*)take((size_t)XCD_BAR_WORDS * 4 + 288 * 64);
  p.cnt = p.bar + XCD_BAR_WORDS;
  p.xch = (unsigned long long*)take((size_t)288 * 4 * 256 * 8);
  if (off > ws_size) { fprintf(stderr, "kernel_launch: workspace too small: need %zu have %zu\n", off, ws_size); return; }
  for (int i = 0; i < 8; ++i) p.ax_inv[i] = pow(10000.0, -(double)i / 8.0);
  for (int i = 0; i < 16; ++i) p.ret_inv[i] = pow(10000.0, -(double)i / 15.0);
  hipMemsetAsync(p.bar, 0, (size_t)XCD_BAR_WORDS * 4 + 288 * 64, stream);
#if MULTI_LAUNCH
  for (int ph = 0; ph < NPHASE; ++ph) {
    hipLaunchKernelGGL(mk, dim3(grid_blocks), dim3(NTHREADS), LDS_BYTES, stream, p, ph, ph + 1);
  }
#else
  int ph0 = 0, ph1 = NPHASE;
  void* args[] = {&p, &ph0, &ph1};
  hipError_t e = hipLaunchCooperativeKernel((const void*)mk, dim3(grid_blocks), dim3(NTHREADS), args, LDS_BYTES, stream);
  if (e != hipSuccess) fprintf(stderr, "cooperative launch failed: %s (grid %d)\n", hipGetErrorString(e), grid_blocks);
#endif
}
```

```cpp
#include <hip/hip_runtime.h>
#include <hip/hip_cooperative_groups.h>
#include <cstdio>
#include <cmath>
namespace cg = cooperative_groups;

#ifndef MULTI_LAUNCH
#define MULTI_LAUNCH 0
#endif

typedef unsigned short bf16_t;
typedef short bf16x8 __attribute__((ext_vector_type(8)));
typedef short bf16x4 __attribute__((ext_vector_type(4)));
typedef float f32x4 __attribute__((ext_vector_type(4)));
typedef float f32x16 __attribute__((ext_vector_type(16)));
typedef unsigned u32x4 __attribute__((ext_vector_type(4)));
typedef unsigned u32x2 __attribute__((ext_vector_type(2)));

constexpr int NLAT = 65536, NCTX = 8192, MTOT = 73728, DM = 1024, DIN = 1984, DFF = 2816;
constexpr int NTHREADS = 512;
constexpr int LDS_BYTES = 140 * 1024;
constexpr float EPS = 1e-6f;
constexpr float ALPHA = 1.681792830507429f;
constexpr int NPL = 10;
constexpr int NPHASE = 2 + 4 * NPL;
constexpr int GQ = 0, GK = 128, GV = 256, GLR = 512, GG = 544, RQ = 800, RK = 928, RV = 1056, RG = 1312, MCQ = 1568, MCKV = 1824, MKR = 1952;
constexpr int USTR = 264;

struct Params {
  const float *x, *c, *ctx, *c_ctx, *ada_w, *ada_b, *w_in, *gate_w, *gate_b, *gla_g, *ret_decay, *qn_g, *kvn_g, *w_uq, *w_uk, *w_uv,
      *w_out, *ln1_g, *ln1_b, *ffn_up, *conv_w, *conv_b, *ffn_down, *ln2_g, *ln2_b;
  float* out;
  float* X; bf16_t* H; bf16_t* P; bf16_t* HA; bf16_t* HU; bf16_t* ACT; bf16_t* Q; bf16_t* Kn; bf16_t* Vt; bf16_t* Kr; bf16_t* St; float* dec; float* rstd; float* lnst;
  float* mod; float* ropetab; float* rettab;
  bf16_t *Wt_in, *Wt_uq, *Wt_uk, *Wt_uv, *Wt_out, *Wt_up, *Wt_down;
  unsigned* bar; unsigned long long* xch; unsigned* cnt;
  double ax_inv[8]; double ret_inv[16];
};

typedef __bf16 bf2_t __attribute__((ext_vector_type(2)));
typedef float f2_t __attribute__((ext_vector_type(2)));
__device__ __forceinline__ unsigned pk2(float lo, float hi) { const f2_t v = {lo, hi}; return __builtin_bit_cast(unsigned, __builtin_convertvector(v, bf2_t)); }
__device__ __forceinline__ bf16_t f2bf(float f) { return (bf16_t)(pk2(f, 0.f) & 0xffffu); }
__device__ __forceinline__ float bf2f(bf16_t v) { return __uint_as_float(((unsigned)v) << 16); }
__device__ __forceinline__ float bflo(unsigned w) { return __uint_as_float(w << 16); }
__device__ __forceinline__ float bfhi(unsigned w) { return __uint_as_float(w & 0xffff0000u); }
__device__ __forceinline__ float silu_f(float v) { return v * __builtin_amdgcn_rcpf(1.f + __expf(-v)); }
__device__ __forceinline__ float logsigmoid_f(float z) { return fminf(z, 0.f) - __logf(1.f + __expf(-fabsf(z))); }
__device__ __forceinline__ int otid_impl(int w0) { int t; asm volatile("v_mbcnt_lo_u32_b32 %0, -1, 0\n\tv_mbcnt_hi_u32_b32 %0, -1, %0" : "=v"(t)); return w0 * 64 + t; }
#define otid() otid_impl(w0)
__device__ __forceinline__ int row_bi(int r) { return r < NLAT ? (r >> 11) : 32; }

constexpr int BM = 256, BK = 64, HALF = 128, HT = HALF * BK;
__device__ __forceinline__ int lds_byte(int r, int c) {
  int st = (r >> 4) * 2 + (c >> 5), rr = r & 15, cc = c & 31, ob = rr * 64 + cc * 2;
  return st * 1024 + (ob ^ (((ob >> 9) & 1) << 5));
}
__device__ __forceinline__ void stage_rc(int b, int& R, int& C) {
  int st = b / 1024, sb = b % 1024, swz = sb ^ (((sb >> 9) & 1) << 5);
  R = (st >> 1) * 16 + swz / 64; C = (st & 1) * 32 + (swz % 64) / 2;
}
__device__ __forceinline__ bool tile_next(long L, int nM, int nN, int& pm, int& pn) {
  int nwg = nM * nN; if (L >= nwg) return false;
  int wgid = (int)L; { int q = nwg / 8, r = nwg % 8, xcd = wgid % 8, off = wgid / 8; wgid = (xcd < r ? xcd * (q + 1) : r * (q + 1) + (xcd - r) * q) + off; }
  int nig = 8 * nN, gid = wgid / nig, fm = gid * 8, gsz = min(nM - fm, 8);
  pm = fm + ((wgid % nig) % gsz); pn = (wgid % nig) / gsz; return true;
}

__device__ __forceinline__ bool tile_next_panel(long L, int nM, int& pm, int& pn) {
  const int r = (int)(L >> 8), c = (int)(L & 255);
  pm = r * 64 + (c & 7) * 8 + (c >> 5); pn = (c >> 3) & 3;
  return pm < nM;
}
template <bool OVL, bool PANEL = false, class Epi>
__device__ __forceinline__ void gemm_phase(const bf16_t* __restrict__ A, long lda, const bf16_t* __restrict__ Bt, long ldb, int nM, int nN, int K,
                                           const Epi& epi, bf16_t* shm, int w0) {
#define SA(b, h) (shm + ((b) * 2 + (h)) * HT)
#define SB(b, h) (shm + (4 + (b) * 2 + (h)) * HT)
#define STAGE(Pp, BASE, LD, OFF, br, kt) do { const char* _gp = (const char*)((BASE) + ((long)(br) * (LD) + (long)(kt) * BK)); \
    unsigned _o = (OFF); asm volatile("" : "+v"(_o));     \
    for (int _i = 0; _i < 2; ++_i) { \
      __builtin_amdgcn_global_load_lds((const unsigned*)(_gp + (long)_i * 128 * (LD) + _o), \
        (__attribute__((address_space(3))) unsigned*)((char*)(Pp) + tid * 16 + _i * 8192), 16, 0, 0); } } while (0)
#define LDA(dst, b, h) for (int m = 0; m < 4; ++m) for (int k = 0; k < 2; ++k) \
    dst[m][k] = *reinterpret_cast<const bf16x8*>((char*)SA(b, h) + a_thr + (m * 2 + k) * 1024)
#define LDB(dst, b, h) for (int n = 0; n < 2; ++n) for (int k = 0; k < 2; ++k) \
    dst[n][k] = *reinterpret_cast<const bf16x8*>((char*)SB(b, h) + b_thr + (n * 2 + k) * 1024)
#define MMA(ai, bj, At, Btf) do { __builtin_amdgcn_s_setprio(1); \
    for (int m = 0; m < 4; ++m) for (int n = 0; n < 2; ++n) for (int k = 0; k < 2; ++k) \
      acc[ai][bj][m][n] = __builtin_amdgcn_mfma_f32_16x16x32_bf16(Btf[n][k], At[m][k], acc[ai][bj][m][n], 0, 0, 0); \
    __builtin_amdgcn_s_setprio(0); } while (0)
#define WAIT_V(n) asm volatile("s_waitcnt vmcnt(" #n ")" ::: "memory")
#define WAIT_L(n) asm volatile("s_waitcnt lgkmcnt(" #n ")" ::: "memory")
#define BAR __builtin_amdgcn_s_barrier()
#define SCHED __builtin_amdgcn_sched_barrier(0)
  const int tid = otid();
  const int wid = tid >> 6, lane = tid & 63, wr = wid >> 2, wc = wid & 3, fr = lane & 15, fq = lane >> 4;
  const int nt = K / BK;
  const int thr_sw = (fr * 64 + fq * 16) ^ ((fr >> 3) << 5); const int a_thr = wr * 8192 + thr_sw, b_thr = wc * 4096 + thr_sw;
  unsigned aoff, boff;
  { int _r, _c; stage_rc(tid * 16, _r, _c); aoff = (unsigned)((_r * lda + _c) * 2); boff = (unsigned)((_r * ldb + _c) * 2); }
  int pm, pn;
  bool have = PANEL ? tile_next_panel((long)blockIdx.x, nM, pm, pn) : tile_next((long)blockIdx.x, nM, nN, pm, pn);
  if (have) { const int brow = pm * BM, bcol = pn * BM;
    STAGE(SB(0, 0), Bt, ldb, boff, bcol, 0); STAGE(SA(0, 0), A, lda, aoff, brow, 0);
    STAGE(SB(0, 1), Bt, ldb, boff, bcol + HALF, 0); STAGE(SA(0, 1), A, lda, aoff, brow + HALF, 0); }
  for (int it = 0; have; ++it) {
    const int brow = pm * BM, bcol = pn * BM;
    f32x4 acc[2][2][4][2];
#pragma unroll
    for (int a0 = 0; a0 < 2; ++a0)
#pragma unroll
      for (int a1 = 0; a1 < 2; ++a1)
#pragma unroll
        for (int a2 = 0; a2 < 4; ++a2)
#pragma unroll
          for (int a3 = 0; a3 < 2; ++a3) acc[a0][a1][a2][a3] = (f32x4){0.f, 0.f, 0.f, 0.f};
    bf16x8 At[4][2], B0[2][2], B1[2][2];
    if (wr == 1) BAR;
    WAIT_V(4); BAR;
    STAGE(SB(1, 0), Bt, ldb, boff, bcol, 1); STAGE(SA(1, 0), A, lda, aoff, brow, 1); STAGE(SB(1, 1), Bt, ldb, boff, bcol + HALF, 1);
    WAIT_V(6); BAR;
    for (int t = 0; t < nt - 2; t += 2) {
      LDB(B0, 0, 0); SCHED; LDA(At, 0, 0); STAGE(SA(1, 1), A, lda, aoff, brow + HALF, t + 1);
      WAIT_L(8); BAR; WAIT_L(0); MMA(0, 0, At, B0); BAR; SCHED;
      LDB(B1, 0, 1); STAGE(SB(0, 0), Bt, ldb, boff, bcol, t + 2);
      BAR; WAIT_L(0); MMA(0, 1, At, B1); BAR;
      LDA(At, 0, 1); STAGE(SA(0, 0), A, lda, aoff, brow, t + 2);
      BAR; WAIT_L(0); MMA(1, 0, At, B0); BAR; SCHED;
      STAGE(SB(0, 1), Bt, ldb, boff, bcol + HALF, t + 2);
      WAIT_V(6); BAR; MMA(1, 1, At, B1); BAR;
      LDB(B0, 1, 0); SCHED; LDA(At, 1, 0); STAGE(SA(0, 1), A, lda, aoff, brow + HALF, t + 2);
      WAIT_L(8); BAR; WAIT_L(0); MMA(0, 0, At, B0); BAR; SCHED;
      LDB(B1, 1, 1); STAGE(SB(1, 0), Bt, ldb, boff, bcol, t + 3);
      BAR; WAIT_L(0); MMA(0, 1, At, B1); BAR;
      LDA(At, 1, 1); STAGE(SA(1, 0), A, lda, aoff, brow, t + 3);
      BAR; WAIT_L(0); MMA(1, 0, At, B0); BAR; SCHED;
      STAGE(SB(1, 1), Bt, ldb, boff, bcol + HALF, t + 3);
      WAIT_V(6); BAR; MMA(1, 1, At, B1); BAR;
    }
    { LDB(B0, 0, 0); LDA(At, 0, 0); STAGE(SA(1, 1), A, lda, aoff, brow + HALF, nt - 1);
      BAR; WAIT_L(0); MMA(0, 0, At, B0); BAR;
      LDB(B1, 0, 1); BAR; WAIT_L(0); MMA(0, 1, At, B1); BAR;
      LDA(At, 0, 1); WAIT_V(4); BAR; WAIT_L(0); MMA(1, 0, At, B0); MMA(1, 1, At, B1); BAR; }
    { LDB(B0, 1, 0); LDA(At, 1, 0); WAIT_V(2); BAR; WAIT_L(0); MMA(0, 0, At, B0); BAR;
      LDB(B1, 1, 1); WAIT_V(0); BAR; WAIT_L(0); MMA(0, 1, At, B1); BAR;
      LDA(At, 1, 1); BAR; WAIT_L(0); MMA(1, 0, At, B0); MMA(1, 1, At, B1); BAR; }
    if (wr == 0) BAR;
    const int cpm = pm, cpn = pn;
    have = PANEL ? tile_next_panel((long)(it + 1) * gridDim.x + blockIdx.x, nM, pm, pn) : tile_next((long)(it + 1) * gridDim.x + blockIdx.x, nM, nN, pm, pn);
    if (OVL && have) { const int nbrow = pm * BM, nbcol = pn * BM;
      STAGE(SB(0, 0), Bt, ldb, boff, nbcol, 0); STAGE(SA(0, 0), A, lda, aoff, nbrow, 0);
      STAGE(SB(0, 1), Bt, ldb, boff, nbcol + HALF, 0); STAGE(SA(0, 1), A, lda, aoff, nbrow + HALF, 0); }
    asm volatile("s_nop 15\n\ts_nop 15" ::: "memory");
    { const int tid2 = otid(); epi(acc, cpm, cpn, wr, wc, fr, fq, shm, tid2); }
    if (OVL) WAIT_V(0);
    else if (have) { const int nbrow = pm * BM, nbcol = pn * BM;
      STAGE(SB(0, 0), Bt, ldb, boff, nbcol, 0); STAGE(SA(0, 0), A, lda, aoff, nbrow, 0);
      STAGE(SB(0, 1), Bt, ldb, boff, nbcol + HALF, 0); STAGE(SA(0, 1), A, lda, aoff, nbrow + HALF, 0); }
  }
  __syncthreads();
#undef SA
#undef SB
#undef STAGE
#undef LDA
#undef LDB
#undef MMA
}

#define EPI_LOOP for (int ai = 0; ai < 2; ++ai) for (int bj = 0; bj < 2; ++bj) for (int m = 0; m < 4; ++m) for (int n = 0; n < 2; ++n)
#define EPI_RC asm volatile("" ::: "memory"); const int row = pm * 256 + ai * 128 + wr * 64 + m * 16 + fr; const int col = pn * 256 + bj * 128 + wc * 32 + n * 16 + fq * 4; const f32x4 v = acc[ai][bj][m][n];

struct EpiP {
  bf16_t* P;
  __device__ __forceinline__ void operator()(const f32x4 (&acc)[2][2][4][2], int pm, int pn, int wr, int wc, int fr, int fq, bf16_t* shm, int tid) const {
#pragma unroll
    EPI_LOOP { EPI_RC
      if (col < DIN) { u32x2 w; w.x = pk2(v[0], v[1]); w.y = pk2(v[2], v[3]); *(u32x2*)(P + (long)row * DIN + col) = w; } }
  }
};
struct EpiQ {
  bf16_t* Q; const float* rstd;
  __device__ __forceinline__ void operator()(const f32x4 (&acc)[2][2][4][2], int pm, int pn, int wr, int wc, int fr, int fq, bf16_t* shm, int tid) const {
#pragma unroll
    EPI_LOOP { EPI_RC
      const float s = rstd[2 * row] * (0.10206207261596577f * 1.4426950408889634f);
      u32x2 w; w.x = pk2(v[0] * s, v[1] * s); w.y = pk2(v[2] * s, v[3] * s); *(u32x2*)(Q + (long)row * 768 + col) = w; }
  }
};
struct EpiK {
  bf16_t* Kn; const float* rstd;
  __device__ __forceinline__ void operator()(const f32x4 (&acc)[2][2][4][2], int pm, int pn, int wr_, int wc_, int fr_, int fq_, bf16_t* shm, int tid) const {
    const int wr = tid >> 8, wc = (tid >> 6) & 3, fr = tid & 15, fq = (tid >> 4) & 3;
#pragma unroll
    EPI_LOOP { EPI_RC
      const float s = rstd[2 * row + 1];
      int b, key; if (row < NLAT) { b = row >> 11; key = row & 2047; } else { b = (row - NLAT) >> 8; key = 2048 + ((row - NLAT) & 255); }
      const int h = col >> 6, d = col & 63;
      u32x2 w; w.x = pk2(v[0] * s, v[1] * s); w.y = pk2(v[2] * s, v[3] * s);
      *(u32x2*)(Kn + (((long)(b * 8 + h) * 2304 + key) << 6) + d) = w; }
  }
};
struct EpiVt {
  bf16_t* Vt; const float* rstd;
  __device__ __forceinline__ void operator()(const f32x4 (&acc)[2][2][4][2], int pm, int pn, int wr, int wc, int fr, int fq, bf16_t* shm, int tid) const {
#pragma unroll
    for (int bj = 0; bj < 2; ++bj)
#pragma unroll
      for (int n = 0; n < 2; ++n) {
        asm volatile("" ::: "memory");
        const int col = pn * 256 + bj * 128 + wc * 32 + n * 16 + fq * 4;
        int b, key; if (col < NLAT) { b = col >> 11; key = col & 2047; } else { b = (col - NLAT) >> 8; key = 2048 + ((col - NLAT) & 255); }
        const float s0 = rstd[2 * col + 1], s1 = rstd[2 * col + 3], s2 = rstd[2 * col + 5], s3 = rstd[2 * col + 7];
        bf16_t* base = Vt + ((long)(b * 512 + pm * 256 + wr * 64 + fr)) * 2304 + key;
#pragma unroll
        for (int ai = 0; ai < 2; ++ai)
#pragma unroll
          for (int m = 0; m < 4; ++m) {
            const f32x4 v = acc[ai][bj][m][n];
            u32x2 w; w.x = pk2(v[0] * s0, v[1] * s1); w.y = pk2(v[2] * s2, v[3] * s3);
            *(u32x2*)(base + (long)(ai * 128 + m * 16) * 2304) = w;
          }
      }
  }
};
struct EpiRes {
  float* X; const float* g; const float* stats; const float* lng; const float* lnb;
  __device__ __forceinline__ void operator()(const f32x4 (&acc)[2][2][4][2], int pm, int pn, int wr_, int wc_, int fr_, int fq_, bf16_t* shm, int tid) const {
    const int wr = tid >> 8, wc = (tid >> 6) & 3, fr = tid & 15, fq = (tid >> 4) & 3;
#pragma unroll
    for (int bj = 0; bj < 2; ++bj)
#pragma unroll
      for (int n = 0; n < 2; ++n) {
        asm volatile("" ::: "memory");
        const int col = pn * 256 + bj * 128 + wc * 32 + n * 16 + fq * 4;
        f32x4 lg = {1.f, 1.f, 1.f, 1.f}, lb = {0.f, 0.f, 0.f, 0.f};
        if (stats) { lg = *(const f32x4*)(lng + col); lb = *(const f32x4*)(lnb + col); }
#pragma unroll
        for (int ai = 0; ai < 2; ++ai)
#pragma unroll
          for (int m = 0; m < 4; ++m) {
            const int row = pm * 256 + ai * 128 + wr * 64 + m * 16 + fr;
            const f32x4 v = acc[ai][bj][m][n];
            const f32x4 gv = *(const f32x4*)(g + (long)row_bi(row) * 6144 + col);
            f32x4* xp = (f32x4*)(X + (long)row * DM + col);
            f32x4 xv = *xp;
            if (stats) { const float mu = stats[2 * row], rs = stats[2 * row + 1]; xv = (xv - mu) * rs * lg + lb; }
            xv = xv * ALPHA + gv * v; *xp = xv;
          }
      }
  }
};
struct EpiResLN {
  const Params& p; int l; int fdown;
  __device__ __forceinline__ void operator()(f32x4 (&acc)[2][2][4][2], int pm, int pn, int wr_, int wc_, int fr_, int fq_, bf16_t* shm, int tid) const {
    const int wr = tid >> 8, wc = (tid >> 6) & 3, fr = tid & 15, fq = (tid >> 4) & 3;
    const bool last = (l == 3);
    const float* modl = p.mod + (long)l * 33 * 6144;
    float* X = p.X; float* lnst = p.lnst; bf16_t* H = p.H; unsigned long long* xch = p.xch; unsigned* cnt = p.cnt;
    const float* g = modl + (fdown ? 5120 : 2048);
    const float* stats = (!fdown && l == 0) ? nullptr : p.lnst;
    const float* lng = fdown ? p.ln1_g + l * 1024 : p.ln2_g + (l - 1) * 1024;
    const float* lnb = fdown ? p.ln1_b + l * 1024 : p.ln2_b + (l - 1) * 1024;
    const float* ng = fdown ? p.ln2_g + l * 1024 : p.ln1_g + l * 1024;
    const float* nb = fdown ? p.ln2_b + l * 1024 : p.ln1_b + l * 1024;
    const float* msh = fdown ? p.mod + (long)(l + 1) * 33 * 6144 : modl + 3072;
    const float* msc = fdown ? p.mod + (long)(l + 1) * 33 * 6144 + 1024 : modl + 4096;
    bf16_t* HA = fdown ? nullptr : p.HA;
    float* outp = (fdown && last) ? p.out : nullptr;
    const unsigned gen = (unsigned)(2 * l + 1 + fdown);
    const long bio = (long)row_bi(pm * 256) * 6144;
    f2_t* red = (f2_t*)((char*)shm + 128 * 1024);
    f2_t* rst = (f2_t*)((char*)shm + 128 * 1024 + 8192);
    float s1[8], s2[8];
#pragma unroll
    for (int i = 0; i < 8; ++i) { s1[i] = 0.f; s2[i] = 0.f; }
#pragma unroll
    for (int bj = 0; bj < 2; ++bj)
#pragma unroll
      for (int n = 0; n < 2; ++n) {
        asm volatile("" ::: "memory");
        const int col = pn * 256 + bj * 128 + wc * 32 + n * 16 + fq * 4;
        f32x4 lg = {1.f, 1.f, 1.f, 1.f}, lb = {0.f, 0.f, 0.f, 0.f};
        if (stats) { lg = *(const f32x4*)(lng + col); lb = *(const f32x4*)(lnb + col); }
        const f32x4 gv = *(const f32x4*)(g + bio + col);
#pragma unroll
        for (int ai = 0; ai < 2; ++ai)
#pragma unroll
          for (int m = 0; m < 4; ++m) {
            const int row = pm * 256 + ai * 128 + wr * 64 + m * 16 + fr;
            const f32x4 v = acc[ai][bj][m][n];
            f32x4* xp = (f32x4*)(X + (long)row * DM + col);
            f32x4 xv = *xp;
            if (stats) { const float mu = stats[2 * row], rs = stats[2 * row + 1]; xv = (xv - mu) * rs * lg + lb; }
            xv = xv * ALPHA + gv * v; *xp = xv;
            acc[ai][bj][m][n] = xv;
            s1[ai * 4 + m] += (xv[0] + xv[1]) + (xv[2] + xv[3]);
            s2[ai * 4 + m] += (xv[0] * xv[0] + xv[1] * xv[1]) + (xv[2] * xv[2] + xv[3] * xv[3]);
          }
      }
#pragma unroll
    for (int i = 0; i < 8; ++i) {
      s1[i] += __shfl_xor(s1[i], 16); s1[i] += __shfl_xor(s1[i], 32);
      s2[i] += __shfl_xor(s2[i], 16); s2[i] += __shfl_xor(s2[i], 32);
      if (fq == 0) red[((i >> 2) * 128 + wr * 64 + (i & 3) * 16 + fr) * 4 + wc] = (f2_t){s1[i], s2[i]};
    }
    __syncthreads();
    if (tid < 256) {
      const f2_t a = red[tid * 4], b = red[tid * 4 + 1], c = red[tid * 4 + 2], d = red[tid * 4 + 3];
      const f2_t t = {(a[0] + b[0]) + (c[0] + d[0]), (a[1] + b[1]) + (c[1] + d[1])};
      __hip_atomic_store(xch + ((long)pm * 4 + pn) * 256 + tid, __builtin_bit_cast(unsigned long long, t), __ATOMIC_RELAXED, __HIP_MEMORY_SCOPE_AGENT);
    }
    asm volatile("s_waitcnt vmcnt(0)" ::: "memory");
    __syncthreads();
    if (tid == 0) {
      __hip_atomic_fetch_add(cnt + pm * 16, 1u, __ATOMIC_RELAXED, __HIP_MEMORY_SCOPE_AGENT);
      unsigned sp = 0;
      while (__hip_atomic_load(cnt + pm * 16, __ATOMIC_RELAXED, __HIP_MEMORY_SCOPE_AGENT) < 4u * gen) { __builtin_amdgcn_s_sleep(1); if (++sp > (1u << 22)) break; }
    }
    __syncthreads();
    if (tid < 256) {
      float S1 = 0.f, S2 = 0.f;
#pragma unroll
      for (int q = 0; q < 4; ++q) { const f2_t t = __builtin_bit_cast(f2_t, __hip_atomic_load(xch + ((long)pm * 4 + q) * 256 + tid, __ATOMIC_RELAXED, __HIP_MEMORY_SCOPE_AGENT)); S1 += t[0]; S2 += t[1]; }
      const float mu = S1 * (1.f / 1024.f), var = fmaxf(S2 * (1.f / 1024.f) - mu * mu, 0.f), rs = rsqrtf(var + EPS);
      rst[tid] = (f2_t){mu, rs};
      if (pn == 0 && !outp) { lnst[2 * (pm * 256 + tid)] = mu; lnst[2 * (pm * 256 + tid) + 1] = rs; }
    }
    __syncthreads();
#pragma unroll
    for (int bj = 0; bj < 2; ++bj)
#pragma unroll
      for (int n = 0; n < 2; ++n) {
        asm volatile("" ::: "memory");
        const int col = pn * 256 + bj * 128 + wc * 32 + n * 16 + fq * 4;
        const f32x4 gg = *(const f32x4*)(ng + col), bb = *(const f32x4*)(nb + col);
        f32x4 sh = {0.f, 0.f, 0.f, 0.f}, sc = {0.f, 0.f, 0.f, 0.f};
        if (!outp) { sh = *(const f32x4*)(msh + bio + col); sc = *(const f32x4*)(msc + bio + col); }
#pragma unroll
        for (int ai = 0; ai < 2; ++ai)
#pragma unroll
          for (int m = 0; m < 4; ++m) {
            const int rl = ai * 128 + wr * 64 + m * 16 + fr, row = pm * 256 + rl;
            const f2_t st = rst[rl];
            f32x4 y = (acc[ai][bj][m][n] - st[0]) * st[1] * gg + bb;
            if (outp) { *(f32x4*)(outp + (long)row * DM + col) = y; }
            else {
              y = y * (sc + 1.f) + sh;
              u32x2 w; w.x = pk2(y[0], y[1]); w.y = pk2(y[2], y[3]);
              *(u32x2*)(H + (long)row * DM + col) = w;
              if (HA && (rl == 0 || rl == 255)) *(u32x2*)(HA + (long)(pm * 2 + (rl == 255)) * DM + col) = w;
            }
          }
      }
  }
};
struct EpiU {
  bf16_t* U;
  __device__ __forceinline__ void operator()(const f32x4 (&acc)[2][2][4][2], int pm, int pn, int wr, int wc, int fr, int fq, bf16_t* shm, int tid) const {
#pragma unroll
    EPI_LOOP { EPI_RC
      u32x2 w; w.x = pk2(v[0], v[1]); w.y = pk2(v[2], v[3]); *(u32x2*)(U + (long)row * 5632 + col) = w; }
  }
};

struct EpiConv {
  bf16_t* ACT; const bf16_t* HU; const float* cw; const float* cb;
  __device__ __forceinline__ void operator()(const f32x4 (&acc)[2][2][4][2], int pm, int pn, int wr_, int wc_, int fr_, int fq_, bf16_t* shm, int tid) const {
    bf16_t* Us = shm;
    const int wr = tid >> 8, wc = (tid >> 6) & 3, fr = tid & 15, fq = (tid >> 4) & 3;
#pragma unroll
    for (int ai = 0; ai < 2; ++ai)
#pragma unroll
      for (int bj = 0; bj < 2; ++bj)
#pragma unroll
        for (int m = 0; m < 4; ++m)
#pragma unroll
          for (int n = 0; n < 2; ++n) {
            const f32x4 v = acc[ai][bj][m][n];
            u32x2 w; w.x = pk2(v[0], v[1]); w.y = pk2(v[2], v[3]);
            *(u32x2*)(Us + (ai * 128 + wr * 64 + m * 16 + fr + 1) * USTR + bj * 128 + wc * 32 + n * 16 + fq * 4) = w;
          }
    if (tid < 64) {
      const int after = tid >> 5, c = (tid & 31) * 8;
      u32x4 hv = {0, 0, 0, 0};
      if (pm < 256) {
        if (!after && (pm & 7) != 0) hv = *(const u32x4*)(HU + (long)((pm - 1) * 2 + 1) * 5632 + pn * 256 + c);
        if (after && ((pm + 1) & 7) != 0) hv = *(const u32x4*)(HU + (long)((pm + 1) * 2) * 5632 + pn * 256 + c);
      }
      *(u32x4*)(Us + (after ? 257 : 0) * USTR + c) = hv;
    }
    __syncthreads();
    {
      const int cg = tid & 15, rs = tid >> 4, f0 = pn * 128 + cg * 8;
      float wa[3][8], wg[3][8], ba[8], bg[8];
#pragma unroll
      for (int t = 0; t < 3; ++t)
#pragma unroll
        for (int e = 0; e < 8; e += 4) {
          const f32x4 x = *(const f32x4*)(cw + t * 5632 + f0 + e), y = *(const f32x4*)(cw + t * 5632 + 2816 + f0 + e);
          wa[t][e] = x[0]; wa[t][e + 1] = x[1]; wa[t][e + 2] = x[2]; wa[t][e + 3] = x[3];
          wg[t][e] = y[0]; wg[t][e + 1] = y[1]; wg[t][e + 2] = y[2]; wg[t][e + 3] = y[3];
        }
#pragma unroll
      for (int e = 0; e < 8; e += 4) {
        const f32x4 x = *(const f32x4*)(cb + f0 + e), y = *(const f32x4*)(cb + 2816 + f0 + e);
        ba[e] = x[0]; ba[e + 1] = x[1]; ba[e + 2] = x[2]; ba[e + 3] = x[3]; bg[e] = y[0]; bg[e + 1] = y[1]; bg[e + 2] = y[2]; bg[e + 3] = y[3];
      }
      const bf16_t* up = Us + (rs * 8) * USTR + cg * 8;
      u32x4 a0 = *(const u32x4*)(up), g0 = *(const u32x4*)(up + 128), a1 = *(const u32x4*)(up + USTR), g1 = *(const u32x4*)(up + USTR + 128);
      bf16_t* outp = ACT + (long)(pm * 256 + rs * 8) * DFF + f0;
#pragma unroll
      for (int i = 0; i < 8; ++i) {
        const u32x4 a2 = *(const u32x4*)(up + (i + 2) * USTR), g2 = *(const u32x4*)(up + (i + 2) * USTR + 128);
        float res[8];
#pragma unroll
        for (int e = 0; e < 8; ++e) {
          const unsigned xa0 = a0[e >> 1], xa1 = a1[e >> 1], xa2 = a2[e >> 1], xg0 = g0[e >> 1], xg1 = g1[e >> 1], xg2 = g2[e >> 1];
          const float va0 = (e & 1) ? bfhi(xa0) : bflo(xa0), va1 = (e & 1) ? bfhi(xa1) : bflo(xa1), va2 = (e & 1) ? bfhi(xa2) : bflo(xa2);
          const float vg0 = (e & 1) ? bfhi(xg0) : bflo(xg0), vg1 = (e & 1) ? bfhi(xg1) : bflo(xg1), vg2 = (e & 1) ? bfhi(xg2) : bflo(xg2);
          const float av = va0 * wa[0][e] + va1 * wa[1][e] + va2 * wa[2][e] + ba[e];
          const float gv = vg0 * wg[0][e] + vg1 * wg[1][e] + vg2 * wg[2][e] + bg[e];
          res[e] = silu_f(av) * gv;
        }
        u32x4 w; w.x = pk2(res[0], res[1]); w.y = pk2(res[2], res[3]); w.z = pk2(res[4], res[5]); w.w = pk2(res[6], res[7]);
        *(u32x4*)(outp + (long)i * DFF) = w;
        a0 = a1; g0 = g1; a1 = a2; g1 = g2;
      }
    }
    __syncthreads();
  }
};

__device__ void mod_phase(const Params& p, float* sm, int w0) {
  const int tid = otid();
  for (int task = blockIdx.x; task < 4 * 96; task += gridDim.x) {
    const int l = task / 96, e0 = (task % 96) * 64;
    __syncthreads();
    for (int i = tid; i < 33 * 1024; i += NTHREADS) { const int bi = i >> 10, d = i & 1023; const float cv = bi < 32 ? p.c[bi * 1024 + d] : p.c_ctx[d]; sm[i] = silu_f(cv); }
    __syncthreads();
    const int kg = tid >> 6, col = tid & 63;
    float acc[33];
#pragma unroll
    for (int bi = 0; bi < 33; ++bi) acc[bi] = 0.f;
    const float* w = p.ada_w + ((long)l * 1024 + kg * 128) * 6144 + e0 + col;
    for (int d = 0; d < 128; ++d) {
      const float wv = w[(long)d * 6144];
#pragma unroll
      for (int bi = 0; bi < 33; ++bi) acc[bi] += sm[bi * 1024 + kg * 128 + d] * wv;
    }
    __syncthreads();
#pragma unroll
    for (int bi = 0; bi < 33; ++bi) sm[(kg * 33 + bi) * 64 + col] = acc[bi];
    __syncthreads();
    for (int i = tid; i < 33 * 64; i += NTHREADS) {
      const int bi = i >> 6, cc = i & 63; float s = p.ada_b[l * 6144 + e0 + cc];
#pragma unroll
      for (int k = 0; k < 8; ++k) s += sm[(k * 33 + bi) * 64 + cc];
      p.mod[((long)l * 33 + bi) * 6144 + e0 + cc] = s;
    }
  }
  __syncthreads();
}

__device__ __forceinline__ void sincos_d(double ang, float& c, float& s) {
  const double TWO_PI = 6.283185307179586476925;
  const double n = rint(ang / TWO_PI); const double r = ang - n * TWO_PI, r2 = r * r;
  double tc = 1.0, sc = 1.0, ts = r, ss = r;
  for (int k = 1; k <= 16; ++k) { tc *= -r2 / (double)((2 * k - 1) * (2 * k)); sc += tc; ts *= -r2 / (double)((2 * k) * (2 * k + 1)); ss += ts; }
  c = (float)sc; s = (float)ss;
}
__device__ void table_phase(const Params& p, int w0) {
  const int g = blockIdx.x * NTHREADS + otid();
  if (g < 2048 * 8) {
    const int t = g >> 3, i = g & 7; float c, s;
    sincos_d((double)(t >> 6) * p.ax_inv[i], c, s); p.ropetab[t * 32 + i] = c; p.ropetab[t * 32 + 8 + i] = s;
    sincos_d((double)(t & 63) * p.ax_inv[i], c, s); p.ropetab[t * 32 + 16 + i] = c; p.ropetab[t * 32 + 24 + i] = s;
    sincos_d((double)t * p.ret_inv[i], c, s); p.rettab[t * 32 + i] = c; p.rettab[t * 32 + 16 + i] = s;
    sincos_d((double)t * p.ret_inv[i + 8], c, s); p.rettab[t * 32 + 8 + i] = c; p.rettab[t * 32 + 24 + i] = s;
  }
}

__device__ void convert_phase(const Params& p, int l, int tbeg, int tend, float* sm, int w0) {
  const int tid = otid();
  constexpr int T0 = 512, T1 = T0 + 48, T2 = T1 + 32, T3 = T2 + 32, T4 = T3 + 256, T5 = T4 + 1408, T6 = T5 + 704;
  for (int task = tbeg + blockIdx.x; task < tend; task += gridDim.x) {
    const float* src; bf16_t* dst; int K, N, Kp, nkt, tt; const float* ksc = nullptr; int mode = 0;
    if (task < T0)      { tt = task;      src = p.w_in + (long)l * 1024 * 1984; dst = p.Wt_in; K = 1024; N = 1984; Kp = 1024; nkt = 16; }
    else if (task < T1) { tt = task - T0; src = p.w_uq + (long)l * 256 * 768; dst = p.Wt_uq; K = 256; N = 768; Kp = 256; nkt = 4; ksc = p.qn_g + l * 256; }
    else if (task < T2) { tt = task - T1; src = p.w_uk + (long)l * 128 * 512; dst = p.Wt_uk; K = 128; N = 512; Kp = 256; nkt = 4; ksc = p.kvn_g + l * 128; }
    else if (task < T3) { tt = task - T2; src = p.w_uv + (long)l * 128 * 512; dst = p.Wt_uv; K = 128; N = 512; Kp = 256; nkt = 4; ksc = p.kvn_g + l * 128; }
    else if (task < T4) { tt = task - T3; src = p.w_out + (long)l * 1024 * 1024; dst = p.Wt_out; K = 1024; N = 1024; Kp = 1024; nkt = 16; }
    else if (task < T5) { tt = task - T4; src = p.ffn_up + (long)l * 1024 * 5632; dst = p.Wt_up; K = 1024; N = 5632; Kp = 1024; nkt = 16; mode = 1; }
    else                { tt = task - T5; src = p.ffn_down + (long)l * 2816 * 1024; dst = p.Wt_down; K = 2816; N = 1024; Kp = 2816; nkt = 44; }
    const int n0 = (tt / nkt) * 64, k0 = (tt % nkt) * 64;
    int c0 = n0;
    if (mode == 1) { const int pn = n0 >> 8, j = n0 & 255; c0 = j < 128 ? pn * 128 + j : 2816 + pn * 128 + (j - 128); }
    __syncthreads();
#pragma unroll
    for (int i = 0; i < 8; ++i) {
      const int kk = (tid >> 6) + 8 * i, nn = tid & 63; float v = 0.f;
      if (k0 + kk < K && n0 + nn < N) { v = src[(long)(k0 + kk) * N + c0 + nn]; if (ksc) v *= ksc[k0 + kk]; }
      sm[kk * 65 + nn] = v;
    }
    __syncthreads();
    { const int nn = tid >> 3, kk0 = (tid & 7) * 8; u32x4 w;
      w.x = pk2(sm[(kk0 + 0) * 65 + nn], sm[(kk0 + 1) * 65 + nn]); w.y = pk2(sm[(kk0 + 2) * 65 + nn], sm[(kk0 + 3) * 65 + nn]);
      w.z = pk2(sm[(kk0 + 4) * 65 + nn], sm[(kk0 + 5) * 65 + nn]); w.w = pk2(sm[(kk0 + 6) * 65 + nn], sm[(kk0 + 7) * 65 + nn]);
      *(u32x4*)(dst + (long)(n0 + nn) * Kp + k0 + kk0) = w; }
  }
  __syncthreads();
}

__device__ void ln_phase(const Params& p, int mode, int l, int w0) {
  const int tid = otid(); const int lane = tid & 63, wv = tid >> 6;
  const bool fin = (mode == 2 && l == 3);
  const int nrows = (mode == 0 || (mode == 2 && l < 3) || (mode == 1 && l < 3)) ? MTOT : NLAT;
  const float* lg = mode == 1 ? p.ln1_g + l * 1024 : p.ln2_g + l * 1024;
  const float* lb = mode == 1 ? p.ln1_b + l * 1024 : p.ln2_b + l * 1024;
  const int ml = mode == 0 ? 0 : (mode == 1 ? l : l + 1);
  const int shoff = mode == 1 ? 3072 : 0, scoff = mode == 1 ? 4096 : 1024;
  for (int rb = blockIdx.x * 16 + wv * 2; rb < nrows; rb += gridDim.x * 16) {
    f32x4 v[2][4];
#pragma unroll
    for (int u = 0; u < 2; ++u) {
      const int r = rb + u;
      const float* src = mode == 0 ? (r < NLAT ? p.x + (long)r * 1024 : p.ctx + (long)(r - NLAT) * 1024) : p.X + (long)r * 1024;
#pragma unroll
      for (int i = 0; i < 4; ++i) v[u][i] = __builtin_nontemporal_load((const f32x4*)(src + i * 256 + lane * 4));
    }
#pragma unroll
    for (int u = 0; u < 2; ++u) {
      const int r = rb + u;
      if (mode == 0) {
#pragma unroll
        for (int i = 0; i < 4; ++i) *(f32x4*)(p.X + (long)r * 1024 + i * 256 + lane * 4) = v[u][i];
      } else {
        float s = 0.f;
#pragma unroll
        for (int i = 0; i < 4; ++i) s += (v[u][i][0] + v[u][i][1]) + (v[u][i][2] + v[u][i][3]);
#pragma unroll
        for (int o = 32; o > 0; o >>= 1) s += __shfl_xor(s, o);
        const float mu = s * (1.f / 1024.f); float q = 0.f;
#pragma unroll
        for (int i = 0; i < 4; ++i) { v[u][i] = v[u][i] - mu; q += (v[u][i][0] * v[u][i][0] + v[u][i][1] * v[u][i][1]) + (v[u][i][2] * v[u][i][2] + v[u][i][3] * v[u][i][3]); }
#pragma unroll
        for (int o = 32; o > 0; o >>= 1) q += __shfl_xor(q, o);
        const float rs = rsqrtf(q * (1.f / 1024.f) + EPS);
        if (lane == 0 && !fin) { p.lnst[2 * r] = mu; p.lnst[2 * r + 1] = rs; }
#pragma unroll
        for (int i = 0; i < 4; ++i) { const f32x4 g = *(const f32x4*)(lg + i * 256 + lane * 4), bb = *(const f32x4*)(lb + i * 256 + lane * 4); v[u][i] = v[u][i] * rs * g + bb; }
      }
      if (fin) {
#pragma unroll
        for (int i = 0; i < 4; ++i) *(f32x4*)(p.out + (long)r * 1024 + i * 256 + lane * 4) = v[u][i];
      } else {
        const float* mb = p.mod + ((long)ml * 33 + row_bi(r)) * 6144;
#pragma unroll
        for (int i = 0; i < 4; ++i) {
          const f32x4 sh = *(const f32x4*)(mb + shoff + i * 256 + lane * 4), sc = *(const f32x4*)(mb + scoff + i * 256 + lane * 4);
          const f32x4 h = v[u][i] * (sc + 1.f) + sh;
          u32x2 w; w.x = pk2(h[0], h[1]); w.y = pk2(h[2], h[3]);
          *(u32x2*)(p.H + (long)r * 1024 + i * 256 + lane * 4) = w;
          if (mode == 1 && ((r & 255) == 0 || (r & 255) == 255)) *(u32x2*)(p.HA + (long)((r >> 8) * 2 + ((r & 255) == 255)) * 1024 + i * 256 + lane * 4) = w;
        }
      }
    }
  }
}

__device__ void mlaprep_phase(const Params& p, int w0) {
  const int tid = otid(); const int lane = tid & 63, wv = tid >> 6;
  for (int r = blockIdx.x * 8 + wv; r < MTOT; r += gridDim.x * 8) {
    const bf16_t* pr = p.P + (long)r * DIN;
    const u32x2 cq = *(const u32x2*)(pr + MCQ + lane * 4);
    const unsigned ck = *(const unsigned*)(pr + MCKV + lane * 2);
    float sq = bflo(cq.x) * bflo(cq.x) + bfhi(cq.x) * bfhi(cq.x) + bflo(cq.y) * bflo(cq.y) + bfhi(cq.y) * bfhi(cq.y);
    float sk = bflo(ck) * bflo(ck) + bfhi(ck) * bfhi(ck);
#pragma unroll
    for (int o = 32; o > 0; o >>= 1) { sq += __shfl_xor(sq, o); sk += __shfl_xor(sk, o); }
    if (lane == 0) { p.rstd[2 * r] = rsqrtf(sq * (1.f / 256.f) + EPS); p.rstd[2 * r + 1] = rsqrtf(sk * (1.f / 128.f) + EPS); }
    const float kv = bf2f(pr[MKR + (lane & 31)]);
    float outv = kv; int b, key;
    if (r < NLAT) {
      b = r >> 11; key = r & 2047;
      const float other = __shfl_xor(kv, 8);
      const int i = lane & 7, part = (lane >> 4) & 1;
      const float cs = p.ropetab[key * 32 + part * 16 + i], sn = p.ropetab[key * 32 + part * 16 + 8 + i];
      outv = (lane & 8) ? (other * sn + kv * cs) : (kv * cs - other * sn);
    } else { b = (r - NLAT) >> 8; key = 2048 + ((r - NLAT) & 255); }
    if (lane < 32) p.Kr[((long)b * 2304 + key) * 32 + lane] = f2bf(outv);
  }
}

constexpr int SSTR = 72;
__device__ __forceinline__ int chunk_row0(int b, int c) { return c < 4 ? NLAT + b * 256 + c * 64 : b * 2048 + (c - 4) * 64; }
__device__ __forceinline__ f32x4 mma16(const bf16_t* A, const bf16_t* B, f32x4 acc, int fr, int fq) {
  const bf16x8 a = *(const bf16x8*)(A + fr * SSTR + fq * 8), b = *(const bf16x8*)(B + fr * SSTR + fq * 8);
  return __builtin_amdgcn_mfma_f32_16x16x32_bf16(a, b, acc, 0, 0, 0);
}

__device__ __forceinline__ long state_idx(int mx, int b, int h, int dir, int c) { return ((((long)(mx * 32 + b) * 4 + h) * 2 + dir) * 36 + c); }

struct ScanPre { u32x2 kw, qw, kp, qp, lw; u32x4 vw, gw; f32x4 cs, sn; float w[16]; float bias; u32x4 st; };

template <bool C>
__device__ __forceinline__ void scan_fetch(const Params& p, int l, int task, int tid, ScanPre& R) {
  const int c = task % 36, h = (task / 36) & 3, b = (task / 144) & 31, mx = task / 4608;
  const int row0 = chunk_row0(b, c);
  const int qoff = (mx ? RQ : GQ) + h * 32, koff = (mx ? RK : GK) + h * 32, voff = (mx ? RV : GV) + h * 64;
  const int s = tid >> 3, d0 = (tid & 7) * 4;
  const bf16_t* pr = p.P + (long)(row0 + s) * DIN;
  R.kw = *(const u32x2*)(pr + koff + d0);
  if (C) R.qw = *(const u32x2*)(pr + qoff + d0);
  if (mx == 1 && c >= 4) {
    const int dp = d0 ^ 16, i0 = d0 & 15, t = (c - 4) * 64 + s;
    R.kp = *(const u32x2*)(pr + koff + dp);
    if (C) R.qp = *(const u32x2*)(pr + qoff + dp);
    R.cs = *(const f32x4*)(p.rettab + t * 32 + i0); R.sn = *(const f32x4*)(p.rettab + t * 32 + 16 + i0);
  }
  R.vw = *(const u32x4*)(pr + voff + (tid & 7) * 8);
  const int gd = tid & 31, gdir = (tid >> 5) & 1;
  if (mx == 0) {
    R.lw = *(const u32x2*)(pr + GLR + d0);
#pragma unroll
    for (int r = 0; r < 16; ++r) R.w[r] = p.gate_w[(((long)l * 2 + gdir) * 16 + r) * 128 + h * 32 + gd];
    R.bias = p.gate_b[((long)l * 2 + gdir) * 128 + h * 32 + gd];
  } else R.bias = p.ret_decay[((long)l * 2 + gdir) * 4 + h];
  if (C) {
    R.gw = *(const u32x4*)(pr + (mx ? RG : GG) + h * 64 + (tid & 7) * 8);
    R.st = *(const u32x4*)(p.St + state_idx(mx, b, h, tid >> 8, c) * 2048 + (tid & 255) * 8);
  }
}

template <bool C>
__device__ __forceinline__ void scan_stage1(const ScanPre& R, int mx, int c, int tid, float* lrs, bf16_t* VT, float (&kv)[4], float (&qv)[4]) {
  const int s = tid >> 3, d0 = (tid & 7) * 4;
  kv[0] = bflo(R.kw.x); kv[1] = bfhi(R.kw.x); kv[2] = bflo(R.kw.y); kv[3] = bfhi(R.kw.y);
  qv[0] = qv[1] = qv[2] = qv[3] = 0.f;
  if (C) { qv[0] = bflo(R.qw.x); qv[1] = bfhi(R.qw.x); qv[2] = bflo(R.qw.y); qv[3] = bfhi(R.qw.y); }
  if (mx == 1 && c >= 4) {
    const float kpv[4] = {bflo(R.kp.x), bfhi(R.kp.x), bflo(R.kp.y), bfhi(R.kp.y)};
    float qpv[4] = {0.f, 0.f, 0.f, 0.f};
    if (C) { qpv[0] = bflo(R.qp.x); qpv[1] = bfhi(R.qp.x); qpv[2] = bflo(R.qp.y); qpv[3] = bfhi(R.qp.y); }
#pragma unroll
    for (int j = 0; j < 4; ++j) {
      const float cs = R.cs[j], sn = R.sn[j];
      if (d0 < 16) { kv[j] = kv[j] * cs - kpv[j] * sn; qv[j] = qv[j] * cs - qpv[j] * sn; }
      else         { kv[j] = kpv[j] * sn + kv[j] * cs; qv[j] = qpv[j] * sn + qv[j] * cs; }
    }
  }
  const int e0 = (tid & 7) * 8;
#pragma unroll
  for (int j = 0; j < 4; ++j) { VT[(e0 + 2 * j) * SSTR + s] = (bf16_t)(R.vw[j] & 0xffffu); VT[(e0 + 2 * j + 1) * SSTR + s] = (bf16_t)(R.vw[j] >> 16); }
  if (mx == 0) { *(f32x4*)(lrs + s * 32 + d0) = (f32x4){bflo(R.lw.x), bfhi(R.lw.x), bflo(R.lw.y), bfhi(R.lw.y)}; }
}

__device__ __forceinline__ void scan_stage2(const ScanPre& R, int mx, int tid, const float* lrs, float* tot, float (&a)[8]) {
  const int d = tid & 31, dir = (tid >> 5) & 1, sg = tid >> 6;
  if (mx == 0) {
#pragma unroll
    for (int j = 0; j < 8; ++j) {
      float z = R.bias;
#pragma unroll
      for (int r = 0; r < 16; r += 4) { const f32x4 lv = *(const f32x4*)(lrs + (sg * 8 + j) * 32 + dir * 16 + r); z += lv[0] * R.w[r] + lv[1] * R.w[r + 1] + lv[2] * R.w[r + 2] + lv[3] * R.w[r + 3]; }
      a[j] = logsigmoid_f(z) * (1.f / 16.f);
    }
  } else {
    const float lg = logsigmoid_f(R.bias);
#pragma unroll
    for (int j = 0; j < 8; ++j) a[j] = lg;
  }
  if (dir == 0) {
#pragma unroll
    for (int j = 1; j < 8; ++j) a[j] += a[j - 1];
  } else {
#pragma unroll
    for (int j = 6; j >= 0; --j) a[j] += a[j + 1];
  }
  tot[sg * 64 + dir * 32 + d] = dir == 0 ? a[7] : a[0];
}
__device__ __forceinline__ void scan_stage3(int tid, const float* tot, float* bc, const float (&a)[8]) {
  const int d = tid & 31, dir = (tid >> 5) & 1, sg = tid >> 6;
  float off = 0.f;
#pragma unroll
  for (int g = 0; g < 8; ++g) { const float tv = tot[g * 64 + dir * 32 + d]; if (dir == 0 ? (g < sg) : (g > sg)) off += tv; }
#pragma unroll
  for (int j = 0; j < 8; ++j) bc[(dir * 64 + sg * 8 + j) * 32 + d] = a[j] + off;
}

__device__ void scanA_phase(const Params& p, int l, char* shm, int w0) {
  float* bc = (float*)shm; float* lrs = bc + 4096; float* tot = lrs + 2048;
  bf16_t* VT = (bf16_t*)(tot + 512); bf16_t* KHT = VT + 64 * SSTR;
  const int tid = otid(), wv = tid >> 6, lane = tid & 63, fr = lane & 15, fq = lane >> 4;
  const int NT = 2 * 32 * 4 * 36;
  ScanPre R;
  int task = blockIdx.x;
  if (task < NT) scan_fetch<false>(p, l, task, tid, R);
  for (; task < NT; task += gridDim.x) {
    const int c = task % 36, h = (task / 36) & 3, b = (task / 144) & 31, mx = task / 4608;
    float kv[4], qv[4], a[8];
    __syncthreads();
    scan_stage1<false>(R, mx, c, tid, lrs, VT, kv, qv);
    __syncthreads();
    scan_stage2(R, mx, tid, lrs, tot, a);
    if (task + (int)gridDim.x < NT) scan_fetch<false>(p, l, task + gridDim.x, tid, R);
    __syncthreads();
    scan_stage3(tid, tot, bc, a);
    __syncthreads();
    { const int s = tid >> 3, d0 = (tid & 7) * 4;
#pragma unroll
      for (int dir = 0; dir < 2; ++dir) {
        const f32x4 bv = *(const f32x4*)(bc + (dir * 64 + s) * 32 + d0), be = *(const f32x4*)(bc + (dir * 64 + (dir ? 0 : 63)) * 32 + d0);
#pragma unroll
        for (int j = 0; j < 4; ++j) KHT[(dir * 32 + d0 + j) * SSTR + s] = f2bf(kv[j] * __expf(be[j] - bv[j]));
      }
      if (tid < 64) { const int d = tid & 31, dir = tid >> 5; p.dec[state_idx(mx, b, h, dir, c) * 32 + d] = __expf(bc[(dir * 64 + (dir ? 0 : 63)) * 32 + d]); }
    }
    __syncthreads();
#pragma unroll
    for (int q = 0; q < 2; ++q) {
      const int id = wv * 2 + q, dir = id >> 3, dti = (id >> 2) & 1, eti = id & 3;
      f32x4 acc = {0.f, 0.f, 0.f, 0.f};
#pragma unroll
      for (int ks = 0; ks < 2; ++ks) acc = mma16(KHT + (dir * 32 + dti * 16) * SSTR + ks * 32, VT + (eti * 16) * SSTR + ks * 32, acc, fr, fq);
      asm volatile("s_nop 15\n\ts_nop 15" : "+v"(acc[0]), "+v"(acc[1]), "+v"(acc[2]), "+v"(acc[3]));
      u32x2 wst; wst.x = pk2(acc[0], acc[1]); wst.y = pk2(acc[2], acc[3]);
      *(u32x2*)(p.St + state_idx(mx, b, h, dir, c) * 2048 + (eti * 16 + fr) * 32 + dti * 16 + fq * 4) = wst;
    }
  }
  __syncthreads();
}

__device__ void scanB_phase(const Params& p, int w0) {
  const int tid = otid();
  for (int task = blockIdx.x; task < 512 * 2; task += gridDim.x) {
    const int chain = task >> 1, i = ((task & 1) * 512 + tid) * 2, d = i & 31, dir = chain & 1;
    bf16_t* st = p.St + (long)chain * 36 * 2048 + i; const float* dc = p.dec + (long)chain * 36 * 32 + d;
    unsigned loc[36]; float dv0[36], dv1[36];
#pragma unroll
    for (int k = 0; k < 36; ++k) { const int c = dir == 0 ? k : (k < 4 ? 3 - k : 39 - k); loc[k] = *(const unsigned*)(st + (long)c * 2048); dv0[k] = dc[c * 32]; dv1[k] = dc[c * 32 + 1]; }
    float r0 = 0.f, r1 = 0.f;
#pragma unroll
    for (int k = 0; k < 36; ++k) { const int c = dir == 0 ? k : (k < 4 ? 3 - k : 39 - k); *(unsigned*)(st + (long)c * 2048) = pk2(r0, r1); r0 = r0 * dv0[k] + bflo(loc[k]); r1 = r1 * dv1[k] + bfhi(loc[k]); }
  }
}

__device__ void scanC_phase(const Params& p, int l, bool last, char* shm, int w0) {
  float* bc = (float*)shm; float* lrs = bc + 4096; float* tot = lrs + 2048;
  bf16_t* VT = (bf16_t*)(tot + 512); bf16_t* QFB = VT + 64 * SSTR; bf16_t* KFB = QFB + 64 * SSTR; bf16_t* ST = KFB + 64 * SSTR; bf16_t* ATT = ST + 64 * SSTR;
  float* O = (float*)(ATT + 64 * SSTR);
  const int tid = otid(), wv = tid >> 6, lane = tid & 63, fr = lane & 15, fq = lane >> 4;
  const float qscale = 0.17677669529663687f;
  const int NT = 2 * 32 * 4 * 36, G = gridDim.x;
  auto nextt = [&](int t) { t += G; while (last && t < NT && (t % 36) < 4) t += G; return t; };
  ScanPre R;
  int task = (int)blockIdx.x - G; task = nextt(task);
  if (task < NT) scan_fetch<true>(p, l, task, tid, R);
  for (; task < NT;) {
    const int c = task % 36, h = (task / 36) & 3, b = (task / 144) & 31, mx = task / 4608;
    const int ntask = nextt(task);
    float kv[4], qv[4], a[8];
    __syncthreads();
    scan_stage1<true>(R, mx, c, tid, lrs, VT, kv, qv);
    { const int idx = (tid & 255) * 8; *(u32x4*)(ST + (idx >> 5) * SSTR + (tid >> 8) * 32 + (idx & 31)) = R.st; }
    const u32x4 gw = R.gw;
    __syncthreads();
    scan_stage2(R, mx, tid, lrs, tot, a);
    if (ntask < NT) scan_fetch<true>(p, l, ntask, tid, R);
    __syncthreads();
    scan_stage3(tid, tot, bc, a);
    __syncthreads();
    { const int s = tid >> 3, d0 = (tid & 7) * 4;
#pragma unroll
      for (int dir = 0; dir < 2; ++dir) {
        const f32x4 bv = *(const f32x4*)(bc + (dir * 64 + s) * 32 + d0);
        float qx[4], kx[4];
#pragma unroll
        for (int j = 0; j < 4; ++j) { qx[j] = qv[j] * qscale * __expf(bv[j]); kx[j] = kv[j] * __expf(-bv[j]); }
        u32x2 wq, wk; wq.x = pk2(qx[0], qx[1]); wq.y = pk2(qx[2], qx[3]); wk.x = pk2(kx[0], kx[1]); wk.y = pk2(kx[2], kx[3]);
        *(u32x2*)(QFB + s * SSTR + dir * 32 + d0) = wq; *(u32x2*)(KFB + s * SSTR + dir * 32 + d0) = wk;
      }
    }
    __syncthreads();
#pragma unroll
    for (int q = 0; q < 2; ++q) {
      const int id = wv * 2 + q, tt = id >> 2, ts = id & 3;
      f32x4 af = {0.f, 0.f, 0.f, 0.f}, ab = {0.f, 0.f, 0.f, 0.f};
      if (ts <= tt) af = mma16(QFB + tt * 16 * SSTR, KFB + ts * 16 * SSTR, af, fr, fq);
      if (ts >= tt) ab = mma16(QFB + tt * 16 * SSTR + 32, KFB + ts * 16 * SSTR + 32, ab, fr, fq);
#pragma unroll
      for (int j = 0; j < 4; ++j) {
        const int t = tt * 16 + fq * 4 + j, s = ts * 16 + fr;
        const float v = (s <= t ? af[j] : 0.f) + (s >= t ? ab[j] : 0.f);
        ATT[t * SSTR + s] = f2bf(v);
      }
    }
    __syncthreads();
#pragma unroll
    for (int q = 0; q < 2; ++q) {
      const int id = wv * 2 + q, tt = id >> 2, et = id & 3;
      f32x4 acc = {0.f, 0.f, 0.f, 0.f};
#pragma unroll
      for (int ks = 0; ks < 2; ++ks) {
        acc = mma16(ATT + tt * 16 * SSTR + ks * 32, VT + et * 16 * SSTR + ks * 32, acc, fr, fq);
        acc = mma16(QFB + tt * 16 * SSTR + ks * 32, ST + et * 16 * SSTR + ks * 32, acc, fr, fq);
      }
#pragma unroll
      for (int j = 0; j < 4; ++j) O[(tt * 16 + fq * 4 + j) * 65 + et * 16 + fr] = acc[j];
    }
    __syncthreads();
    { const int t = tid >> 3, e0 = (tid & 7) * 8; float o[8]; float s = 0.f;
#pragma unroll
      for (int j = 0; j < 8; ++j) { o[j] = O[t * 65 + e0 + j]; s += o[j]; }
      s += __shfl_xor(s, 1); s += __shfl_xor(s, 2); s += __shfl_xor(s, 4);
      const float mu = mx == 1 ? s * (1.f / 64.f) : 0.f; float qq = 0.f;
#pragma unroll
      for (int j = 0; j < 8; ++j) { o[j] -= mu; qq += o[j] * o[j]; }
      qq += __shfl_xor(qq, 1); qq += __shfl_xor(qq, 2); qq += __shfl_xor(qq, 4);
      const float rs = rsqrtf(qq * (1.f / 64.f) + EPS);
      const int row = chunk_row0(b, c) + t;
      float r[8];
#pragma unroll
      for (int j = 0; j < 8; ++j) {
        const unsigned w = gw[j >> 1]; const float gt = (j & 1) ? bfhi(w) : bflo(w);
        float y = o[j] * rs; if (mx == 0) y *= p.gla_g[l * 64 + e0 + j];
        r[j] = y * silu_f(gt);
      }
      u32x4 w; w.x = pk2(r[0], r[1]); w.y = pk2(r[2], r[3]); w.z = pk2(r[4], r[5]); w.w = pk2(r[6], r[7]);
      *(u32x4*)(p.H + (long)row * 1024 + mx * 256 + h * 64 + e0) = w;
    }
    task = ntask;
  }
  __syncthreads();
}

constexpr int KSTR = 104, VSTR = 72;
__device__ void attn_phase(const Params& p, bool last, char* shm, int w0) {
  bf16_t* Ks = (bf16_t*)shm;
  bf16_t* Vs = Ks + 2 * 64 * KSTR;
  const int tid = otid(), wv = tid >> 6, lane = tid & 63, lq = lane & 31, hb = lane >> 5;
  const int ntask = 1024 + (last ? 0 : 256);
  for (int task = blockIdx.x; task < ntask; task += gridDim.x) {
    int b, h, qrow0, nkeys, key0, nwav;
    if (task < 1024) { b = task >> 5; h = (task >> 2) & 7; qrow0 = b * 2048 + (task & 3) * 512; nkeys = 2304; key0 = 0; nwav = 8; }
    else { const int t = task - 1024; b = t >> 3; h = t & 7; qrow0 = NLAT + b * 256; nkeys = 256; key0 = 2048; nwav = 4; }
    const bool act = wv < nwav;
    bf16x8 qf[2][6];
    if (act) {
#pragma unroll
      for (int qt = 0; qt < 2; ++qt) {
        const int row = qrow0 + wv * 64 + qt * 32 + lq; const bf16_t* qp = p.Q + (long)row * 768 + h * 96;
#pragma unroll
        for (int ks = 0; ks < 4; ++ks) qf[qt][ks] = *(const bf16x8*)(qp + ks * 16 + hb * 8);
#pragma unroll
        for (int ks = 4; ks < 6; ++ks) {
          const bf16x8 own = *(const bf16x8*)(qp + ks * 16 + hb * 8);
          if (task < 1024) {
            const bf16x8 oth = *(const bf16x8*)(qp + ks * 16 + (hb ^ 1) * 8);
            const int t = row & 2047; const float* tb = p.ropetab + t * 32 + (ks - 4) * 16;
            bf16x8 r;
#pragma unroll
            for (int i = 0; i < 8; i += 2) {
              const float cs0 = tb[i], sn0 = tb[8 + i], cs1 = tb[i + 1], sn1 = tb[9 + i];
              const float o0 = bf2f((bf16_t)own[i]), o1 = bf2f((bf16_t)own[i + 1]), x0 = bf2f((bf16_t)oth[i]), x1 = bf2f((bf16_t)oth[i + 1]);
              const float r0 = hb ? (x0 * sn0 + o0 * cs0) : (o0 * cs0 - x0 * sn0);
              const float r1 = hb ? (x1 * sn1 + o1 * cs1) : (o1 * cs1 - x1 * sn1);
              const unsigned w = pk2(r0, r1); r[i] = (short)(w & 0xffffu); r[i + 1] = (short)(w >> 16);
            }
            qf[qt][ks] = r;
          } else qf[qt][ks] = own;
        }
      }
    }
    f32x16 ot[2][2];
#pragma unroll
    for (int i = 0; i < 2; ++i)
#pragma unroll
      for (int j = 0; j < 2; ++j)
#pragma unroll
        for (int e = 0; e < 16; ++e) ot[i][j][e] = 0.f;
    float mrun[2] = {0.f, 0.f}, lrun[2] = {0.f, 0.f};
    const bf16_t* Kng = p.Kn + ((long)(b * 8 + h) * 2304 + key0) * 64;
    const bf16_t* Krg = p.Kr + ((long)b * 2304 + key0) * 32;
    const bf16_t* Vtg = p.Vt + ((long)(b * 8 + h) * 64) * 2304 + key0;
    const unsigned offk = (unsigned)tid * 16u, offr = (unsigned)(tid & 255) * 16u, offv = (unsigned)((tid >> 3) * 2304 + (tid & 7) * 8) * 2u;
    const int lk0 = (tid >> 3) * KSTR + (tid & 7) * 8, lk1 = ((tid & 255) >> 2) * KSTR + 64 + (tid & 3) * 8, lv = (tid >> 3) * VSTR + (tid & 7) * 8;
    u32x4 rk0, rk1 = {0, 0, 0, 0}, rv;
    auto gload = [&](int kt) {
      rk0 = *(const u32x4*)((const char*)Kng + (size_t)kt * 8192 + offk);
      if (tid < 256) rk1 = *(const u32x4*)((const char*)Krg + (size_t)kt * 4096 + offr);
      rv = *(const u32x4*)((const char*)Vtg + (size_t)kt * 128 + offv);
    };
    auto lstore = [&](int buf) {
      *(u32x4*)(Ks + buf * 64 * KSTR + lk0) = rk0;
      if (tid < 256) *(u32x4*)(Ks + buf * 64 * KSTR + lk1) = rk1;
      *(u32x4*)(Vs + buf * 64 * VSTR + lv) = rv;
    };
    const int ntile = nkeys / 64;
    __syncthreads();
    gload(0); lstore(0);
    __syncthreads();
    for (int kt = 0; kt < ntile; ++kt) {
      const int buf = kt & 1;
      if (kt + 1 < ntile) gload(kt + 1);
      if (act) {
        const bf16_t* Kb = Ks + buf * 64 * KSTR; const bf16_t* Vb = Vs + buf * 64 * VSTR;
#pragma unroll
        for (int k2 = 0; k2 < 2; ++k2) {
          f32x16 st[2];
#pragma unroll
          for (int j = 0; j < 2; ++j)
#pragma unroll
            for (int e = 0; e < 16; ++e) st[j][e] = -mrun[j];
#pragma unroll
          for (int ks = 0; ks < 6; ++ks) {
            const bf16x8 kf = *(const bf16x8*)(Kb + (k2 * 32 + lq) * KSTR + ks * 16 + hb * 8);
            st[0] = __builtin_amdgcn_mfma_f32_32x32x16_bf16(kf, qf[0][ks], st[0], 0, 0, 0);
            st[1] = __builtin_amdgcn_mfma_f32_32x32x16_bf16(kf, qf[1][ks], st[1], 0, 0, 0);
          }
          bf16x8 pf[2][2];
#pragma unroll
          for (int qt = 0; qt < 2; ++qt) {
            float mx = st[qt][0];
#pragma unroll
            for (int e = 1; e < 16; ++e) mx = fmaxf(mx, st[qt][e]);
            mx = fmaxf(mx, __shfl_xor(mx, 32));
            const bool first = (kt == 0 && k2 == 0);
            if (first || __builtin_amdgcn_ballot_w64(mx > 6.f) != 0ull) {
              const float delta = first ? mx : fmaxf(mx, 0.f);
              const float alpha = first ? 1.f : __builtin_amdgcn_exp2f(-delta);
              mrun[qt] += delta;
#pragma unroll
              for (int e = 0; e < 16; ++e) st[qt][e] -= delta;
              lrun[qt] *= alpha;
#pragma unroll
              for (int dt = 0; dt < 2; ++dt)
#pragma unroll
                for (int e = 0; e < 16; ++e) ot[dt][qt][e] *= alpha;
            }
            float ls = 0.f;
#pragma unroll
            for (int s2 = 0; s2 < 2; ++s2) {
              const int g0 = s2 * 2; bf16x8 f;
#pragma unroll
              for (int j = 0; j < 4; j += 2) {
                const float p0 = __builtin_amdgcn_exp2f(st[qt][g0 * 4 + j]), p1 = __builtin_amdgcn_exp2f(st[qt][g0 * 4 + j + 1]);
                const float p2 = __builtin_amdgcn_exp2f(st[qt][(g0 + 1) * 4 + j]), p3 = __builtin_amdgcn_exp2f(st[qt][(g0 + 1) * 4 + j + 1]);
                ls += (p0 + p1) + (p2 + p3);
                const unsigned ww0 = pk2(p0, p1), ww1 = pk2(p2, p3);
                f[j] = (short)(ww0 & 0xffffu); f[j + 1] = (short)(ww0 >> 16); f[4 + j] = (short)(ww1 & 0xffffu); f[4 + j + 1] = (short)(ww1 >> 16);
              }
              pf[qt][s2] = f;
            }
            lrun[qt] += ls;
          }
#pragma unroll
          for (int dt = 0; dt < 2; ++dt)
#pragma unroll
            for (int s2 = 0; s2 < 2; ++s2) {
              const bf16_t* vp = Vb + (dt * 32 + lq) * VSTR + (k2 * 2 + s2) * 16 + hb * 4;
              const bf16x4 v0 = *(const bf16x4*)vp, v1 = *(const bf16x4*)(vp + 8);
              bf16x8 vf; vf[0] = v0[0]; vf[1] = v0[1]; vf[2] = v0[2]; vf[3] = v0[3]; vf[4] = v1[0]; vf[5] = v1[1]; vf[6] = v1[2]; vf[7] = v1[3];
              ot[dt][0] = __builtin_amdgcn_mfma_f32_32x32x16_bf16(vf, pf[0][s2], ot[dt][0], 0, 0, 0);
              ot[dt][1] = __builtin_amdgcn_mfma_f32_32x32x16_bf16(vf, pf[1][s2], ot[dt][1], 0, 0, 0);
            }
        }
      }
      if (kt + 1 < ntile) lstore(buf ^ 1);
      __syncthreads();
    }
    if (act) {
#pragma unroll
      for (int qt = 0; qt < 2; ++qt) {
        const float lt = lrun[qt] + __shfl_xor(lrun[qt], 32); const float inv = 1.f / lt;
        const int row = qrow0 + wv * 64 + qt * 32 + lq; bf16_t* op = p.H + (long)row * 1024 + 512 + h * 64;
#pragma unroll
        for (int dt = 0; dt < 2; ++dt)
#pragma unroll
          for (int g = 0; g < 4; ++g) {
            u32x2 w; w.x = pk2(ot[dt][qt][g * 4] * inv, ot[dt][qt][g * 4 + 1] * inv); w.y = pk2(ot[dt][qt][g * 4 + 2] * inv, ot[dt][qt][g * 4 + 3] * inv);
            *(u32x2*)(op + dt * 32 + g * 8 + hb * 4) = w;
          }
      }
    }
  }
  __syncthreads();
}

#define XB_TMO      128
#define XB_XCNT(j)  (256  + 64 * (j))
#define XB_XSUB(j)  (1280 + 64 * (j))
#define XB_XGEN(j)  (2304 + 64 * (j))
#define XB_TOP      3328
#define XB_TOPGEN   3392
#define XCD_BAR_WORDS 3456
#define XB_SPIN_CAP (1u << 18)
#define LAS __attribute__((address_space(3)))
__device__ __forceinline__ unsigned xb_ld(unsigned* p)              { return __hip_atomic_load(p, __ATOMIC_RELAXED, __HIP_MEMORY_SCOPE_AGENT); }
__device__ __forceinline__ unsigned xb_add(unsigned* p, unsigned v) { return __hip_atomic_fetch_add(p, v, __ATOMIC_RELAXED, __HIP_MEMORY_SCOPE_AGENT); }
__device__ __forceinline__ unsigned xb_xcc_id() { return (unsigned)__builtin_amdgcn_s_getreg((3 << 11) | 20) & 0xFu; }
#define XB_SPIN(cond, bar) do { unsigned _sp = 0; while (cond) { __builtin_amdgcn_s_sleep(1); \
    if ((++_sp & 255u) == 0u) { if (xb_ld(&(bar)[XB_TMO])) break; if (_sp > XB_SPIN_CAP) { atomicAdd(&(bar)[XB_TMO], 1u); break; } } } } while (0)
struct XcdBarrier { unsigned* bar; unsigned x; volatile LAS unsigned* st; };
__device__ __forceinline__ XcdBarrier xcd_barrier_post(unsigned* bar, volatile LAS unsigned* st, int tid) {
  XcdBarrier b; b.bar = bar; b.x = xb_xcc_id(); b.st = st;
  if (tid == 0) (void)xb_add(&bar[XB_XCNT(b.x)], 1u);
  return b;
}
__device__ __forceinline__ void xcd_barrier_complete(unsigned* bar, unsigned x, unsigned& nloc, unsigned& nx) {
  const unsigned G = gridDim.x * gridDim.y * gridDim.z;
  unsigned sum, cnt, mine, sp = 0u;
  for (;;) {
    sum = 0u; cnt = 0u; mine = 0u;
#pragma unroll
    for (unsigned j = 0; j < 16; ++j) { const unsigned c = xb_ld(&bar[XB_XCNT(j)]); sum += c; cnt += (c > 0u) ? 1u : 0u; mine = (j == x) ? c : mine; }
    if (sum == G) break;
    __builtin_amdgcn_s_sleep(1);
    if ((++sp & 255u) == 0u) { if (xb_ld(&bar[XB_TMO])) break; if (sp > XB_SPIN_CAP) { atomicAdd(&bar[XB_TMO], 1u); break; } }
  }
  nloc = mine > 0u ? mine : 1u; nx = cnt > 0u ? cnt : 1u;
}
__device__ __forceinline__ void xcd_barrier(unsigned* bar_, volatile LAS unsigned* st_, int tid) {
  XcdBarrier b; b.bar = bar_; b.st = st_; b.x = xb_xcc_id();
  asm volatile("s_waitcnt vmcnt(0)" ::: "memory");
  __syncthreads();
  if (tid == 0) {
    unsigned* bar = b.bar;
    __builtin_amdgcn_s_waitcnt(0);
    unsigned nloc = b.st[0], nx = b.st[1];
    if (nloc == 0u) { xcd_barrier_complete(bar, b.x, nloc, nx); b.st[0] = nloc; b.st[1] = nx; }
    const unsigned old = xb_add(&bar[XB_XSUB(b.x)], 1u);
    const unsigned gen = old / nloc;
    if (old + 1u == (gen + 1u) * nloc) {
      __builtin_amdgcn_fence(__ATOMIC_RELEASE, "agent");
      asm volatile("s_waitcnt vmcnt(0)" ::: "memory");
      const unsigned og = xb_add(&bar[XB_TOP], 1u);
      const unsigned tg = og / nx;
      if (og + 1u == (tg + 1u) * nx) xb_add(&bar[XB_TOPGEN], 1u);
      else XB_SPIN(xb_ld(&bar[XB_TOPGEN]) == tg, bar);
      __builtin_amdgcn_fence(__ATOMIC_ACQUIRE, "agent");
      xb_add(&bar[XB_XGEN(b.x)], 1u);
      asm volatile("s_waitcnt vmcnt(0)" ::: "memory");
    } else {
      XB_SPIN(xb_ld(&bar[XB_XGEN(b.x)]) == gen, bar);
      __builtin_amdgcn_fence(__ATOMIC_ACQUIRE, "agent");
      asm volatile("s_waitcnt vmcnt(0)" ::: "memory");
    }
  }
  __syncthreads();
}

__device__ void run_phase(const Params& p, int ph, char* shm, int w0) {
  if (ph == 0) { mod_phase(p, (float*)shm, w0); table_phase(p, w0); convert_phase(p, 0, 0, 2992, (float*)shm, w0); return; }
  if (ph == 1) { ln_phase(p, 0, 0, w0); return; }
  const int l = (ph - 2) / NPL, s = (ph - 2) % NPL; const bool last = (l == 3);
  const float* modl = p.mod + (long)l * 33 * 6144;
  bf16_t* sh = (bf16_t*)shm;
  switch (s) {
    case 0: { EpiP e{p.P}; gemm_phase<true>(p.H, 1024, p.Wt_in, 1024, MTOT / 256, 8, 1024, e, sh, w0); } break;
    case 1: scanA_phase(p, l, shm, w0); mlaprep_phase(p, w0); if (l > 0) convert_phase(p, l, 2288, 2992, (float*)shm, w0); break;
    case 2: { scanB_phase(p, w0); EpiVt e{p.Vt, p.rstd}; gemm_phase<true>(p.Wt_uv, 256, p.P + MCKV, DIN, 2, MTOT / 256, 256, e, sh, w0); } break;
    case 3: scanC_phase(p, l, last, shm, w0); break;
    case 4: { EpiQ e{p.Q, p.rstd}; gemm_phase<true>(p.P + MCQ, DIN, p.Wt_uq, 256, (last ? NLAT : MTOT) / 256, 3, 256, e, sh, w0);
              EpiK e2{p.Kn, p.rstd}; gemm_phase<true>(p.P + MCKV, DIN, p.Wt_uk, 256, MTOT / 256, 2, 256, e2, sh, w0); } break;
    case 5: attn_phase(p, last, shm, w0); break;
    case 6: { EpiResLN e{p, l, 0}; gemm_phase<true, true>(p.H, 1024, p.Wt_out, 1024, (last ? NLAT : MTOT) / 256, 4, 1024, e, sh, w0); } break;
    case 7: { EpiU e{p.HU}; gemm_phase<true>(p.HA, 1024, p.Wt_up, 1024, 3, 22, 1024, e, sh, w0);
              if (!last) convert_phase(p, l + 1, 0, 880, (float*)shm, w0); } break;
    case 8: { EpiConv e{p.ACT, p.HU, p.conv_w + (long)l * 3 * 5632, p.conv_b + (long)l * 5632}; gemm_phase<false>(p.H, 1024, p.Wt_up, 1024, (last ? NLAT : MTOT) / 256, 22, 1024, e, sh, w0); } break;
    case 9: { EpiResLN e{p, l, 1}; gemm_phase<true, true>(p.ACT, DFF, p.Wt_down, DFF, (last ? NLAT : MTOT) / 256, 4, DFF, e, sh, w0);
              if (!last) convert_phase(p, l + 1, 880, 2288, (float*)shm, w0); } break;
  }
}

__global__ void __launch_bounds__(NTHREADS) mk(Params p, int ph0, int ph1) {
  extern __shared__ __attribute__((aligned(16))) char shm[];
  __shared__ uint4 xb_words;
  cg::grid_group grid = cg::this_grid();
  const int w0 = __builtin_amdgcn_readfirstlane((int)(threadIdx.x >> 6));
  {
    const int tid = otid();
    if (tid == 0) xb_words = make_uint4(0u, 0u, 0u, 0u);
    __syncthreads();
  }
  { const int tid = otid(); (void)xcd_barrier_post(p.bar, (volatile LAS unsigned*)&xb_words, tid); }
  if (ph1 < 0) grid.sync();
  for (int ph = ph0; ph < ph1; ++ph) {
    run_phase(p, ph, shm, w0);
    if (ph + 1 < ph1) {
      { const int tid = otid(); xcd_barrier(p.bar, (volatile LAS unsigned*)&xb_words, tid); }
    }
  }
}

extern "C" void kernel_launch(void* const* d_in, const int* in_sizes, int n_in, void* d_out, int out_size, void* d_ws, size_t ws_size, hipStream_t stream) {
  static int grid_blocks = 0;
  if (!grid_blocks) {
    int dev = 0, cus = 0, per_cu = 0;
    hipGetDevice(&dev);
    hipDeviceGetAttribute(&cus, hipDeviceAttributeMultiprocessorCount, dev);
    hipFuncSetAttribute((const void*)mk, hipFuncAttributeMaxDynamicSharedMemorySize, LDS_BYTES);
    hipOccupancyMaxActiveBlocksPerMultiprocessor(&per_cu, mk, NTHREADS, LDS_BYTES);
    if (per_cu < 1) per_cu = 1;
    grid_blocks = cus * per_cu;
    (void)hipGetLastError();
  }
  Params p{};
  const float** pin = (const float**)&p.x;
  for (int i = 0; i < 25; ++i) pin[i] = (const float*)d_in[i];
  p.out = (float*)d_out;
  char* w = (char*)d_ws; size_t off = 0;
  auto take = [&](size_t bytes) { char* r = w + off; off += (bytes + 255) & ~(size_t)255; return r; };
  p.X = (float*)take((size_t)MTOT * 1024 * 4);
  p.H = (bf16_t*)take((size_t)MTOT * 1024 * 2);
  p.P = (bf16_t*)take((size_t)MTOT * DIN * 2 + 4096);
  p.ACT = p.P;
  p.Q = (bf16_t*)take((size_t)MTOT * 768 * 2);
  p.Kn = (bf16_t*)take((size_t)32 * 8 * 2304 * 64 * 2);
  p.St = p.Q;
  p.Vt = (bf16_t*)take((size_t)32 * 8 * 64 * 2304 * 2);
  p.Kr = (bf16_t*)take((size_t)32 * 2304 * 32 * 2);
  p.HA = (bf16_t*)take((size_t)768 * 1024 * 2);
  p.HU = (bf16_t*)take((size_t)768 * 5632 * 2);
  p.dec = (float*)take((size_t)512 * 36 * 32 * 4);
  p.rstd = (float*)take((size_t)MTOT * 2 * 4 + 64);
  p.lnst = (float*)take((size_t)MTOT * 2 * 4);
  p.mod = (float*)take((size_t)4 * 33 * 6144 * 4);
  p.ropetab = (float*)take(2048 * 32 * 4);
  p.rettab = (float*)take(2048 * 32 * 4);
  p.Wt_in = (bf16_t*)take((size_t)2048 * 1024 * 2);
  p.Wt_uq = (bf16_t*)take((size_t)768 * 256 * 2);
  p.Wt_uk = (bf16_t*)take((size_t)512 * 256 * 2);
  p.Wt_uv = (bf16_t*)take((size_t)512 * 256 * 2);
  p.Wt_out = (bf16_t*)take((size_t)1024 * 1024 * 2);
  p.Wt_up = (bf16_t*)take((size_t)5632 * 1024 * 2);
  p.Wt_down = (bf16_t*)take((size_t)1024 * 2816 * 2);
  p.bar = (unsigned*)take((size_t)XCD_BAR_WORDS * 4 + 288 * 64);
  p.cnt = p.bar + XCD_BAR_WORDS;
  p.xch = (unsigned long long*)take((size_t)288 * 4 * 256 * 8);
  if (off > ws_size) { fprintf(stderr, "kernel_launch: workspace too small: need %zu have %zu\n", off, ws_size); return; }
  for (int i = 0; i < 8; ++i) p.ax_inv[i] = pow(10000.0, -(double)i / 8.0);
  for (int i = 0; i < 16; ++i) p.ret_inv[i] = pow(10000.0, -(double)i / 15.0);
  hipMemsetAsync(p.bar, 0, (size_t)XCD_BAR_WORDS * 4 + 288 * 64, stream);
#if MULTI_LAUNCH
  for (int ph = 0; ph < NPHASE; ++ph) {
    hipLaunchKernelGGL(mk, dim3(grid_blocks), dim3(NTHREADS), LDS_BYTES, stream, p, ph, ph + 1);
  }
#else
  int ph0 = 0, ph1 = NPHASE;
  void* args[] = {&p, &ph0, &ph1};
  hipError_t e = hipLaunchCooperativeKernel((const void*)mk, dim3(grid_blocks), dim3(NTHREADS), args, LDS_BYTES, stream);
  if (e != hipSuccess) fprintf(stderr, "cooperative launch failed: %s (grid %d)\n", hipGetErrorString(e), grid_blocks);
#endif
}
```

```cpp
#include <hip/hip_runtime.h>
#include <hip/hip_cooperative_groups.h>
#include <cstdio>
#include <cmath>
namespace cg = cooperative_groups;

#ifndef MULTI_LAUNCH
#define MULTI_LAUNCH 0
#endif

typedef unsigned short bf16_t;
typedef short bf16x8 __attribute__((ext_vector_type(8)));
typedef short bf16x4 __attribute__((ext_vector_type(4)));
typedef float f32x4 __attribute__((ext_vector_type(4)));
typedef float f32x16 __attribute__((ext_vector_type(16)));
typedef unsigned u32x4 __attribute__((ext_vector_type(4)));
typedef unsigned u32x2 __attribute__((ext_vector_type(2)));

constexpr int NLAT = 65536, NCTX = 8192, MTOT = 73728, DM = 1024, DIN = 1984, DFF = 2816;
constexpr int NTHREADS = 512;
constexpr int LDS_BYTES = 140 * 1024;
constexpr float EPS = 1e-6f;
constexpr float ALPHA = 1.681792830507429f;
constexpr int NPL = 10;
constexpr int NPHASE = 2 + 4 * NPL;
constexpr int GQ = 0, GK = 128, GV = 256, GLR = 512, GG = 544, RQ = 800, RK = 928, RV = 1056, RG = 1312, MCQ = 1568, MCKV = 1824, MKR = 1952;
constexpr int USTR = 264;

struct Params {
  const float *x, *c, *ctx, *c_ctx, *ada_w, *ada_b, *w_in, *gate_w, *gate_b, *gla_g, *ret_decay, *qn_g, *kvn_g, *w_uq, *w_uk, *w_uv,
      *w_out, *ln1_g, *ln1_b, *ffn_up, *conv_w, *conv_b, *ffn_down, *ln2_g, *ln2_b;
  float* out;
  float* X; bf16_t* H; bf16_t* P; bf16_t* HA; bf16_t* HU; bf16_t* ACT; bf16_t* Q; bf16_t* Kn; bf16_t* Vt; bf16_t* Kr; bf16_t* St; float* dec; float* rstd; float* lnst;
  float* mod; float* ropetab; float* rettab;
  bf16_t *Wt_in, *Wt_uq, *Wt_uk, *Wt_uv, *Wt_out, *Wt_up, *Wt_down;
  unsigned* bar; unsigned long long* xch; unsigned* cnt;
  double ax_inv[8]; double ret_inv[16];
};

typedef __bf16 bf2_t __attribute__((ext_vector_type(2)));
typedef float f2_t __attribute__((ext_vector_type(2)));
__device__ __forceinline__ unsigned pk2(float lo, float hi) { const f2_t v = {lo, hi}; return __builtin_bit_cast(unsigned, __builtin_convertvector(v, bf2_t)); }
__device__ __forceinline__ bf16_t f2bf(float f) { return (bf16_t)(pk2(f, 0.f) & 0xffffu); }
__device__ __forceinline__ float bf2f(bf16_t v) { return __uint_as_float(((unsigned)v) << 16); }
__device__ __forceinline__ float bflo(unsigned w) { return __uint_as_float(w << 16); }
__device__ __forceinline__ float bfhi(unsigned w) { return __uint_as_float(w & 0xffff0000u); }
__device__ __forceinline__ float silu_f(float v) { return v * __builtin_amdgcn_rcpf(1.f + __expf(-v)); }
__device__ __forceinline__ float logsigmoid_f(float z) { return fminf(z, 0.f) - __logf(1.f + __expf(-fabsf(z))); }
__device__ __forceinline__ int otid_impl(int w0) { int t; asm volatile("v_mbcnt_lo_u32_b32 %0, -1, 0\n\tv_mbcnt_hi_u32_b32 %0, -1, %0" : "=v"(t)); return w0 * 64 + t; }
#define otid() otid_impl(w0)
__device__ __forceinline__ int row_bi(int r) { return r < NLAT ? (r >> 11) : 32; }

constexpr int BM = 256, BK = 64, HALF = 128, HT = HALF * BK;
__device__ __forceinline__ int lds_byte(int r, int c) {
  int st = (r >> 4) * 2 + (c >> 5), rr = r & 15, cc = c & 31, ob = rr * 64 + cc * 2;
  return st * 1024 + (ob ^ (((ob >> 9) & 1) << 5));
}
__device__ __forceinline__ void stage_rc(int b, int& R, int& C) {
  int st = b / 1024, sb = b % 1024, swz = sb ^ (((sb >> 9) & 1) << 5);
  R = (st >> 1) * 16 + swz / 64; C = (st & 1) * 32 + (swz % 64) / 2;
}
__device__ __forceinline__ bool tile_next(long L, int nM, int nN, int& pm, int& pn) {
  int nwg = nM * nN; if (L >= nwg) return false;
  int wgid = (int)L; { int q = nwg / 8, r = nwg % 8, xcd = wgid % 8, off = wgid / 8; wgid = (xcd < r ? xcd * (q + 1) : r * (q + 1) + (xcd - r) * q) + off; }
  int nig = 8 * nN, gid = wgid / nig, fm = gid * 8, gsz = min(nM - fm, 8);
  pm = fm + ((wgid % nig) % gsz); pn = (wgid % nig) / gsz; return true;
}

__device__ __forceinline__ bool tile_next_panel(long L, int nM, int& pm, int& pn) {
  const int r = (int)(L >> 8), c = (int)(L & 255);
  pm = r * 64 + (c & 7) * 8 + (c >> 5); pn = (c >> 3) & 3;
  return pm < nM;
}
template <bool OVL, bool PANEL = false, class Epi>
__device__ __forceinline__ void gemm_phase(const bf16_t* __restrict__ A, long lda, const bf16_t* __restrict__ Bt, long ldb, int nM, int nN, int K,
                                           const Epi& epi, bf16_t* shm, int w0) {
#define SA(b, h) (shm + ((b) * 2 + (h)) * HT)
#define SB(b, h) (shm + (4 + (b) * 2 + (h)) * HT)
#define STAGE(Pp, BASE, LD, OFF, br, kt) do { const char* _gp = (const char*)((BASE) + ((long)(br) * (LD) + (long)(kt) * BK)); \
    unsigned _o = (OFF); asm volatile("" : "+v"(_o));     \
    for (int _i = 0; _i < 2; ++_i) { \
      __builtin_amdgcn_global_load_lds((const unsigned*)(_gp + (long)_i * 128 * (LD) + _o), \
        (__attribute__((address_space(3))) unsigned*)((char*)(Pp) + tid * 16 + _i * 8192), 16, 0, 0); } } while (0)
#define LDA(dst, b, h) for (int m = 0; m < 4; ++m) for (int k = 0; k < 2; ++k) \
    dst[m][k] = *reinterpret_cast<const bf16x8*>((char*)SA(b, h) + a_thr + (m * 2 + k) * 1024)
#define LDB(dst, b, h) for (int n = 0; n < 2; ++n) for (int k = 0; k < 2; ++k) \
    dst[n][k] = *reinterpret_cast<const bf16x8*>((char*)SB(b, h) + b_thr + (n * 2 + k) * 1024)
#define MMA(ai, bj, At, Btf) do { __builtin_amdgcn_s_setprio(1); \
    for (int m = 0; m < 4; ++m) for (int n = 0; n < 2; ++n) for (int k = 0; k < 2; ++k) \
      acc[ai][bj][m][n] = __builtin_amdgcn_mfma_f32_16x16x32_bf16(Btf[n][k], At[m][k], acc[ai][bj][m][n], 0, 0, 0); \
    __builtin_amdgcn_s_setprio(0); } while (0)
#define WAIT_V(n) asm volatile("s_waitcnt vmcnt(" #n ")" ::: "memory")
#define WAIT_L(n) asm volatile("s_waitcnt lgkmcnt(" #n ")" ::: "memory")
#define BAR __builtin_amdgcn_s_barrier()
#define SCHED __builtin_amdgcn_sched_barrier(0)
  const int tid = otid();
  const int wid = tid >> 6, lane = tid & 63, wr = wid >> 2, wc = wid & 3, fr = lane & 15, fq = lane >> 4;
  const int nt = K / BK;
  const int thr_sw = (fr * 64 + fq * 16) ^ ((fr >> 3) << 5); const int a_thr = wr * 8192 + thr_sw, b_thr = wc * 4096 + thr_sw;
  unsigned aoff, boff;
  { int _r, _c; stage_rc(tid * 16, _r, _c); aoff = (unsigned)((_r * lda + _c) * 2); boff = (unsigned)((_r * ldb + _c) * 2); }
  int pm, pn;
  bool have = PANEL ? tile_next_panel((long)blockIdx.x, nM, pm, pn) : tile_next((long)blockIdx.x, nM, nN, pm, pn);
  if (have) { const int brow = pm * BM, bcol = pn * BM;
    STAGE(SB(0, 0), Bt, ldb, boff, bcol, 0); STAGE(SA(0, 0), A, lda, aoff, brow, 0);
    STAGE(SB(0, 1), Bt, ldb, boff, bcol + HALF, 0); STAGE(SA(0, 1), A, lda, aoff, brow + HALF, 0); }
  for (int it = 0; have; ++it) {
    const int brow = pm * BM, bcol = pn * BM;
    f32x4 acc[2][2][4][2];
#pragma unroll
    for (int a0 = 0; a0 < 2; ++a0)
#pragma unroll
      for (int a1 = 0; a1 < 2; ++a1)
#pragma unroll
        for (int a2 = 0; a2 < 4; ++a2)
#pragma unroll
          for (int a3 = 0; a3 < 2; ++a3) acc[a0][a1][a2][a3] = (f32x4){0.f, 0.f, 0.f, 0.f};
    bf16x8 At[4][2], B0[2][2], B1[2][2];
    if (wr == 1) BAR;
    WAIT_V(4); BAR;
    STAGE(SB(1, 0), Bt, ldb, boff, bcol, 1); STAGE(SA(1, 0), A, lda, aoff, brow, 1); STAGE(SB(1, 1), Bt, ldb, boff, bcol + HALF, 1);
    WAIT_V(6); BAR;
    for (int t = 0; t < nt - 2; t += 2) {
      LDB(B0, 0, 0); SCHED; LDA(At, 0, 0); STAGE(SA(1, 1), A, lda, aoff, brow + HALF, t + 1);
      WAIT_L(8); BAR; WAIT_L(0); MMA(0, 0, At, B0); BAR; SCHED;
      LDB(B1, 0, 1); STAGE(SB(0, 0), Bt, ldb, boff, bcol, t + 2);
      BAR; WAIT_L(0); MMA(0, 1, At, B1); BAR;
      LDA(At, 0, 1); STAGE(SA(0, 0), A, lda, aoff, brow, t + 2);
      BAR; WAIT_L(0); MMA(1, 0, At, B0); BAR; SCHED;
      STAGE(SB(0, 1), Bt, ldb, boff, bcol + HALF, t + 2);
      WAIT_V(6); BAR; MMA(1, 1, At, B1); BAR;
      LDB(B0, 1, 0); SCHED; LDA(At, 1, 0); STAGE(SA(0, 1), A, lda, aoff, brow + HALF, t + 2);
      WAIT_L(8); BAR; WAIT_L(0); MMA(0, 0, At, B0); BAR; SCHED;
      LDB(B1, 1, 1); STAGE(SB(1, 0), Bt, ldb, boff, bcol, t + 3);
      BAR; WAIT_L(0); MMA(0, 1, At, B1); BAR;
      LDA(At, 1, 1); STAGE(SA(1, 0), A, lda, aoff, brow, t + 3);
      BAR; WAIT_L(0); MMA(1, 0, At, B0); BAR; SCHED;
      STAGE(SB(1, 1), Bt, ldb, boff, bcol + HALF, t + 3);
      WAIT_V(6); BAR; MMA(1, 1, At, B1); BAR;
    }
    { LDB(B0, 0, 0); LDA(At, 0, 0); STAGE(SA(1, 1), A, lda, aoff, brow + HALF, nt - 1);
      BAR; WAIT_L(0); MMA(0, 0, At, B0); BAR;
      LDB(B1, 0, 1); BAR; WAIT_L(0); MMA(0, 1, At, B1); BAR;
      LDA(At, 0, 1); WAIT_V(4); BAR; WAIT_L(0); MMA(1, 0, At, B0); MMA(1, 1, At, B1); BAR; }
    { LDB(B0, 1, 0); LDA(At, 1, 0); WAIT_V(2); BAR; WAIT_L(0); MMA(0, 0, At, B0); BAR;
      LDB(B1, 1, 1); WAIT_V(0); BAR; WAIT_L(0); MMA(0, 1, At, B1); BAR;
      LDA(At, 1, 1); BAR; WAIT_L(0); MMA(1, 0, At, B0); MMA(1, 1, At, B1); BAR; }
    if (wr == 0) BAR;
    const int cpm = pm, cpn = pn;
    have = PANEL ? tile_next_panel((long)(it + 1) * gridDim.x + blockIdx.x, nM, pm, pn) : tile_next((long)(it + 1) * gridDim.x + blockIdx.x, nM, nN, pm, pn);
    if (OVL && have) { const int nbrow = pm * BM, nbcol = pn * BM;
      STAGE(SB(0, 0), Bt, ldb, boff, nbcol, 0); STAGE(SA(0, 0), A, lda, aoff, nbrow, 0);
      STAGE(SB(0, 1), Bt, ldb, boff, nbcol + HALF, 0); STAGE(SA(0, 1), A, lda, aoff, nbrow + HALF, 0); }
    asm volatile("s_nop 15\n\ts_nop 15" ::: "memory");
    { const int tid2 = otid(); epi(acc, cpm, cpn, wr, wc, fr, fq, shm, tid2); }
    if (OVL) WAIT_V(0);
    else if (have) { const int nbrow = pm * BM, nbcol = pn * BM;
      STAGE(SB(0, 0), Bt, ldb, boff, nbcol, 0); STAGE(SA(0, 0), A, lda, aoff, nbrow, 0);
      STAGE(SB(0, 1), Bt, ldb, boff, nbcol + HALF, 0); STAGE(SA(0, 1), A, lda, aoff, nbrow + HALF, 0); }
  }
  __syncthreads();
#undef SA
#undef SB
#undef STAGE
#undef LDA
#undef LDB
#undef MMA
}

#define EPI_LOOP for (int ai = 0; ai < 2; ++ai) for (int bj = 0; bj < 2; ++bj) for (int m = 0; m < 4; ++m) for (int n = 0; n < 2; ++n)
#define EPI_RC asm volatile("" ::: "memory"); const int row = pm * 256 + ai * 128 + wr * 64 + m * 16 + fr; const int col = pn * 256 + bj * 128 + wc * 32 + n * 16 + fq * 4; const f32x4 v = acc[ai][bj][m][n];

struct EpiP {
  bf16_t* P;
  __device__ __forceinline__ void operator()(const f32x4 (&acc)[2][2][4][2], int pm, int pn, int wr, int wc, int fr, int fq, bf16_t* shm, int tid) const {
#pragma unroll
    EPI_LOOP { EPI_RC
      if (col < DIN) { u32x2 w; w.x = pk2(v[0], v[1]); w.y = pk2(v[2], v[3]); *(u32x2*)(P + (long)row * DIN + col) = w; } }
  }
};
struct EpiQ {
  bf16_t* Q; const float* rstd;
  __device__ __forceinline__ void operator()(const f32x4 (&acc)[2][2][4][2], int pm, int pn, int wr, int wc, int fr, int fq, bf16_t* shm, int tid) const {
#pragma unroll
    EPI_LOOP { EPI_RC
      const float s = rstd[2 * row] * (0.10206207261596577f * 1.4426950408889634f);
      u32x2 w; w.x = pk2(v[0] * s, v[1] * s); w.y = pk2(v[2] * s, v[3] * s); *(u32x2*)(Q + (long)row * 768 + col) = w; }
  }
};
struct EpiK {
  bf16_t* Kn; const float* rstd;
  __device__ __forceinline__ void operator()(const f32x4 (&acc)[2][2][4][2], int pm, int pn, int wr_, int wc_, int fr_, int fq_, bf16_t* shm, int tid) const {
    const int wr = tid >> 8, wc = (tid >> 6) & 3, fr = tid & 15, fq = (tid >> 4) & 3;
#pragma unroll
    EPI_LOOP { EPI_RC
      const float s = rstd[2 * row + 1];
      int b, key; if (row < NLAT) { b = row >> 11; key = row & 2047; } else { b = (row - NLAT) >> 8; key = 2048 + ((row - NLAT) & 255); }
      const int h = col >> 6, d = col & 63;
      u32x2 w; w.x = pk2(v[0] * s, v[1] * s); w.y = pk2(v[2] * s, v[3] * s);
      *(u32x2*)(Kn + (((long)(b * 8 + h) * 2304 + key) << 6) + d) = w; }
  }
};
struct EpiVt {
  bf16_t* Vt; const float* rstd;
  __device__ __forceinline__ void operator()(const f32x4 (&acc)[2][2][4][2], int pm, int pn, int wr, int wc, int fr, int fq, bf16_t* shm, int tid) const {
#pragma unroll
    for (int bj = 0; bj < 2; ++bj)
#pragma unroll
      for (int n = 0; n < 2; ++n) {
        asm volatile("" ::: "memory");
        const int col = pn * 256 + bj * 128 + wc * 32 + n * 16 + fq * 4;
        int b, key; if (col < NLAT) { b = col >> 11; key = col & 2047; } else { b = (col - NLAT) >> 8; key = 2048 + ((col - NLAT) & 255); }
        const float s0 = rstd[2 * col + 1], s1 = rstd[2 * col + 3], s2 = rstd[2 * col + 5], s3 = rstd[2 * col + 7];
        bf16_t* base = Vt + ((long)(b * 512 + pm * 256 + wr * 64 + fr)) * 2304 + key;
#pragma unroll
        for (int ai = 0; ai < 2; ++ai)
#pragma unroll
          for (int m = 0; m < 4; ++m) {
            const f32x4 v = acc[ai][bj][m][n];
            u32x2 w; w.x = pk2(v[0] * s0, v[1] * s1); w.y = pk2(v[2] * s2, v[3] * s3);
            *(u32x2*)(base + (long)(ai * 128 + m * 16) * 2304) = w;
          }
      }
  }
};
struct EpiRes {
  float* X; const float* g; const float* stats; const float* lng; const float* lnb;
  __device__ __forceinline__ void operator()(const f32x4 (&acc)[2][2][4][2], int pm, int pn, int wr_, int wc_, int fr_, int fq_, bf16_t* shm, int tid) const {
    const int wr = tid >> 8, wc = (tid >> 6) & 3, fr = tid & 15, fq = (tid >> 4) & 3;
#pragma unroll
    for (int bj = 0; bj < 2; ++bj)
#pragma unroll
      for (int n = 0; n < 2; ++n) {
        asm volatile("" ::: "memory");
        const int col = pn * 256 + bj * 128 + wc * 32 + n * 16 + fq * 4;
        f32x4 lg = {1.f, 1.f, 1.f, 1.f}, lb = {0.f, 0.f, 0.f, 0.f};
        if (stats) { lg = *(const f32x4*)(lng + col); lb = *(const f32x4*)(lnb + col); }
#pragma unroll
        for (int ai = 0; ai < 2; ++ai)
#pragma unroll
          for (int m = 0; m < 4; ++m) {
            const int row = pm * 256 + ai * 128 + wr * 64 + m * 16 + fr;
            const f32x4 v = acc[ai][bj][m][n];
            const f32x4 gv = *(const f32x4*)(g + (long)row_bi(row) * 6144 + col);
            f32x4* xp = (f32x4*)(X + (long)row * DM + col);
            f32x4 xv = *xp;
            if (stats) { const float mu = stats[2 * row], rs = stats[2 * row + 1]; xv = (xv - mu) * rs * lg + lb; }
            xv = xv * ALPHA + gv * v; *xp = xv;
          }
      }
  }
};
struct EpiResLN {
  const Params& p; int l; int fdown;
  __device__ __forceinline__ void operator()(f32x4 (&acc)[2][2][4][2], int pm, int pn, int wr_, int wc_, int fr_, int fq_, bf16_t* shm, int tid) const {
    const int wr = tid >> 8, wc = (tid >> 6) & 3, fr = tid & 15, fq = (tid >> 4) & 3;
    const bool last = (l == 3);
    const float* modl = p.mod + (long)l * 33 * 6144;
    float* X = p.X; float* lnst = p.lnst; bf16_t* H = p.H; unsigned long long* xch = p.xch; unsigned* cnt = p.cnt;
    const float* g = modl + (fdown ? 5120 : 2048);
    const float* stats = (!fdown && l == 0) ? nullptr : p.lnst;
    const float* lng = fdown ? p.ln1_g + l * 1024 : p.ln2_g + (l - 1) * 1024;
    const float* lnb = fdown ? p.ln1_b + l * 1024 : p.ln2_b + (l - 1) * 1024;
    const float* ng = fdown ? p.ln2_g + l * 1024 : p.ln1_g + l * 1024;
    const float* nb = fdown ? p.ln2_b + l * 1024 : p.ln1_b + l * 1024;
    const float* msh = fdown ? p.mod + (long)(l + 1) * 33 * 6144 : modl + 3072;
    const float* msc = fdown ? p.mod + (long)(l + 1) * 33 * 6144 + 1024 : modl + 4096;
    bf16_t* HA = fdown ? nullptr : p.HA;
    float* outp = (fdown && last) ? p.out : nullptr;
    const unsigned gen = (unsigned)(2 * l + 1 + fdown);
    const long bio = (long)row_bi(pm * 256) * 6144;
    f2_t* red = (f2_t*)((char*)shm + 128 * 1024);
    f2_t* rst = (f2_t*)((char*)shm + 128 * 1024 + 8192);
    float s1[8], s2[8];
#pragma unroll
    for (int i = 0; i < 8; ++i) { s1[i] = 0.f; s2[i] = 0.f; }
#pragma unroll
    for (int bj = 0; bj < 2; ++bj)
#pragma unroll
      for (int n = 0; n < 2; ++n) {
        asm volatile("" ::: "memory");
        const int col = pn * 256 + bj * 128 + wc * 32 + n * 16 + fq * 4;
        f32x4 lg = {1.f, 1.f, 1.f, 1.f}, lb = {0.f, 0.f, 0.f, 0.f};
        if (stats) { lg = *(const f32x4*)(lng + col); lb = *(const f32x4*)(lnb + col); }
        const f32x4 gv = *(const f32x4*)(g + bio + col);
#pragma unroll
        for (int ai = 0; ai < 2; ++ai)
#pragma unroll
          for (int m = 0; m < 4; ++m) {
            const int row = pm * 256 + ai * 128 + wr * 64 + m * 16 + fr;
            const f32x4 v = acc[ai][bj][m][n];
            f32x4* xp = (f32x4*)(X + (long)row * DM + col);
            f32x4 xv = *xp;
            if (stats) { const float mu = stats[2 * row], rs = stats[2 * row + 1]; xv = (xv - mu) * rs * lg + lb; }
            xv = xv * ALPHA + gv * v; *xp = xv;
            acc[ai][bj][m][n] = xv;
            s1[ai * 4 + m] += (xv[0] + xv[1]) + (xv[2] + xv[3]);
            s2[ai * 4 + m] += (xv[0] * xv[0] + xv[1] * xv[1]) + (xv[2] * xv[2] + xv[3] * xv[3]);
          }
      }
#pragma unroll
    for (int i = 0; i < 8; ++i) {
      s1[i] += __shfl_xor(s1[i], 16); s1[i] += __shfl_xor(s1[i], 32);
      s2[i] += __shfl_xor(s2[i], 16); s2[i] += __shfl_xor(s2[i], 32);
      if (fq == 0) red[((i >> 2) * 128 + wr * 64 + (i & 3) * 16 + fr) * 4 + wc] = (f2_t){s1[i], s2[i]};
    }
    __syncthreads();
    if (tid < 256) {
      const f2_t a = red[tid * 4], b = red[tid * 4 + 1], c = red[tid * 4 + 2], d = red[tid * 4 + 3];
      const f2_t t = {(a[0] + b[0]) + (c[0] + d[0]), (a[1] + b[1]) + (c[1] + d[1])};
      __hip_atomic_store(xch + ((long)pm * 4 + pn) * 256 + tid, __builtin_bit_cast(unsigned long long, t), __ATOMIC_RELAXED, __HIP_MEMORY_SCOPE_AGENT);
    }
    asm volatile("s_waitcnt vmcnt(0)" ::: "memory");
    __syncthreads();
    if (tid == 0) {
      __hip_atomic_fetch_add(cnt + pm * 16, 1u, __ATOMIC_RELAXED, __HIP_MEMORY_SCOPE_AGENT);
      unsigned sp = 0;
      while (__hip_atomic_load(cnt + pm * 16, __ATOMIC_RELAXED, __HIP_MEMORY_SCOPE_AGENT) < 4u * gen) { __builtin_amdgcn_s_sleep(1); if (++sp > (1u << 22)) break; }
    }
    __syncthreads();
    if (tid < 256) {
      float S1 = 0.f, S2 = 0.f;
#pragma unroll
      for (int q = 0; q < 4; ++q) { const f2_t t = __builtin_bit_cast(f2_t, __hip_atomic_load(xch + ((long)pm * 4 + q) * 256 + tid, __ATOMIC_RELAXED, __HIP_MEMORY_SCOPE_AGENT)); S1 += t[0]; S2 += t[1]; }
      const float mu = S1 * (1.f / 1024.f), var = fmaxf(S2 * (1.f / 1024.f) - mu * mu, 0.f), rs = rsqrtf(var + EPS);
      rst[tid] = (f2_t){mu, rs};
      if (pn == 0 && !outp) { lnst[2 * (pm * 256 + tid)] = mu; lnst[2 * (pm * 256 + tid) + 1] = rs; }
    }
    __syncthreads();
#pragma unroll
    for (int bj = 0; bj < 2; ++bj)
#pragma unroll
      for (int n = 0; n < 2; ++n) {
        asm volatile("" ::: "memory");
        const int col = pn * 256 + bj * 128 + wc * 32 + n * 16 + fq * 4;
        const f32x4 gg = *(const f32x4*)(ng + col), bb = *(const f32x4*)(nb + col);
        f32x4 sh = {0.f, 0.f, 0.f, 0.f}, sc = {0.f, 0.f, 0.f, 0.f};
        if (!outp) { sh = *(const f32x4*)(msh + bio + col); sc = *(const f32x4*)(msc + bio + col); }
#pragma unroll
        for (int ai = 0; ai < 2; ++ai)
#pragma unroll
          for (int m = 0; m < 4; ++m) {
            const int rl = ai * 128 + wr * 64 + m * 16 + fr, row = pm * 256 + rl;
            const f2_t st = rst[rl];
            f32x4 y = (acc[ai][bj][m][n] - st[0]) * st[1] * gg + bb;
            if (outp) { *(f32x4*)(outp + (long)row * DM + col) = y; }
            else {
              y = y * (sc + 1.f) + sh;
              u32x2 w; w.x = pk2(y[0], y[1]); w.y = pk2(y[2], y[3]);
              *(u32x2*)(H + (long)row * DM + col) = w;
              if (HA && (rl == 0 || rl == 255)) *(u32x2*)(HA + (long)(pm * 2 + (rl == 255)) * DM + col) = w;
            }
          }
      }
  }
};
struct EpiU {
  bf16_t* U;
  __device__ __forceinline__ void operator()(const f32x4 (&acc)[2][2][4][2], int pm, int pn, int wr, int wc, int fr, int fq, bf16_t* shm, int tid) const {
#pragma unroll
    EPI_LOOP { EPI_RC
      u32x2 w; w.x = pk2(v[0], v[1]); w.y = pk2(v[2], v[3]); *(u32x2*)(U + (long)row * 5632 + col) = w; }
  }
};

struct EpiConv {
  bf16_t* ACT; const bf16_t* HU; const float* cw; const float* cb;
  __device__ __forceinline__ void operator()(const f32x4 (&acc)[2][2][4][2], int pm, int pn, int wr_, int wc_, int fr_, int fq_, bf16_t* shm, int tid) const {
    bf16_t* Us = shm;
    const int wr = tid >> 8, wc = (tid >> 6) & 3, fr = tid & 15, fq = (tid >> 4) & 3;
#pragma unroll
    for (int ai = 0; ai < 2; ++ai)
#pragma unroll
      for (int bj = 0; bj < 2; ++bj)
#pragma unroll
        for (int m = 0; m < 4; ++m)
#pragma unroll
          for (int n = 0; n < 2; ++n) {
            const f32x4 v = acc[ai][bj][m][n];
            u32x2 w; w.x = pk2(v[0], v[1]); w.y = pk2(v[2], v[3]);
            *(u32x2*)(Us + (ai * 128 + wr * 64 + m * 16 + fr + 1) * USTR + bj * 128 + wc * 32 + n * 16 + fq * 4) = w;
          }
    if (tid < 64) {
      const int after = tid >> 5, c = (tid & 31) * 8;
      u32x4 hv = {0, 0, 0, 0};
      if (pm < 256) {
        if (!after && (pm & 7) != 0) hv = *(const u32x4*)(HU + (long)((pm - 1) * 2 + 1) * 5632 + pn * 256 + c);
        if (after && ((pm + 1) & 7) != 0) hv = *(const u32x4*)(HU + (long)((pm + 1) * 2) * 5632 + pn * 256 + c);
      }
      *(u32x4*)(Us + (after ? 257 : 0) * USTR + c) = hv;
    }
    __syncthreads();
    {
      const int cg = tid & 15, rs = tid >> 4, f0 = pn * 128 + cg * 8;
      float wa[3][8], wg[3][8], ba[8], bg[8];
#pragma unroll
      for (int t = 0; t < 3; ++t)
#pragma unroll
        for (int e = 0; e < 8; e += 4) {
          const f32x4 x = *(const f32x4*)(cw + t * 5632 + f0 + e), y = *(const f32x4*)(cw + t * 5632 + 2816 + f0 + e);
          wa[t][e] = x[0]; wa[t][e + 1] = x[1]; wa[t][e + 2] = x[2]; wa[t][e + 3] = x[3];
          wg[t][e] = y[0]; wg[t][e + 1] = y[1]; wg[t][e + 2] = y[2]; wg[t][e + 3] = y[3];
        }
#pragma unroll
      for (int e = 0; e < 8; e += 4) {
        const f32x4 x = *(const f32x4*)(cb + f0 + e), y = *(const f32x4*)(cb + 2816 + f0 + e);
        ba[e] = x[0]; ba[e + 1] = x[1]; ba[e + 2] = x[2]; ba[e + 3] = x[3]; bg[e] = y[0]; bg[e + 1] = y[1]; bg[e + 2] = y[2]; bg[e + 3] = y[3];
      }
      const bf16_t* up = Us + (rs * 8) * USTR + cg * 8;
      u32x4 a0 = *(const u32x4*)(up), g0 = *(const u32x4*)(up + 128), a1 = *(const u32x4*)(up + USTR), g1 = *(const u32x4*)(up + USTR + 128);
      bf16_t* outp = ACT + (long)(pm * 256 + rs * 8) * DFF + f0;
#pragma unroll
      for (int i = 0; i < 8; ++i) {
        const u32x4 a2 = *(const u32x4*)(up + (i + 2) * USTR), g2 = *(const u32x4*)(up + (i + 2) * USTR + 128);
        float res[8];
#pragma unroll
        for (int e = 0; e < 8; ++e) {
          const unsigned xa0 = a0[e >> 1], xa1 = a1[e >> 1], xa2 = a2[e >> 1], xg0 = g0[e >> 1], xg1 = g1[e >> 1], xg2 = g2[e >> 1];
          const float va0 = (e & 1) ? bfhi(xa0) : bflo(xa0), va1 = (e & 1) ? bfhi(xa1) : bflo(xa1), va2 = (e & 1) ? bfhi(xa2) : bflo(xa2);
          const float vg0 = (e & 1) ? bfhi(xg0) : bflo(xg0), vg1 = (e & 1) ? bfhi(xg1) : bflo(xg1), vg2 = (e & 1) ? bfhi(xg2) : bflo(xg2);
          const float av = va0 * wa[0][e] + va1 * wa[1][e] + va2 * wa[2][e] + ba[e];
          const float gv = vg0 * wg[0][e] + vg1 * wg[1][e] + vg2 * wg[2][e] + bg[e];
          res[e] = silu_f(av) * gv;
        }
        u32x4 w; w.x = pk2(res[0], res[1]); w.y = pk2(res[2], res[3]); w.z = pk2(res[4], res[5]); w.w = pk2(res[6], res[7]);
        *(u32x4*)(outp + (long)i * DFF) = w;
        a0 = a1; g0 = g1; a1 = a2; g1 = g2;
      }
    }
    __syncthreads();
  }
};

__device__ void mod_phase(const Params& p, float* sm, int w0) {
  const int tid = otid();
  for (int task = blockIdx.x; task < 4 * 96; task += gridDim.x) {
    const int l = task / 96, e0 = (task % 96) * 64;
    __syncthreads();
    for (int i = tid; i < 33 * 1024; i += NTHREADS) { const int bi = i >> 10, d = i & 1023; const float cv = bi < 32 ? p.c[bi * 1024 + d] : p.c_ctx[d]; sm[i] = silu_f(cv); }
    __syncthreads();
    const int kg = tid >> 6, col = tid & 63;
    float acc[33];
#pragma unroll
    for (int bi = 0; bi < 33; ++bi) acc[bi] = 0.f;
    const float* w = p.ada_w + ((long)l * 1024 + kg * 128) * 6144 + e0 + col;
    for (int d = 0; d < 128; ++d) {
      const float wv = w[(long)d * 6144];
#pragma unroll
      for (int bi = 0; bi < 33; ++bi) acc[bi] += sm[bi * 1024 + kg * 128 + d] * wv;
    }
    __syncthreads();
#pragma unroll
    for (int bi = 0; bi < 33; ++bi) sm[(kg * 33 + bi) * 64 + col] = acc[bi];
    __syncthreads();
    for (int i = tid; i < 33 * 64; i += NTHREADS) {
      const int bi = i >> 6, cc = i & 63; float s = p.ada_b[l * 6144 + e0 + cc];
#pragma unroll
      for (int k = 0; k < 8; ++k) s += sm[(k * 33 + bi) * 64 + cc];
      p.mod[((long)l * 33 + bi) * 6144 + e0 + cc] = s;
    }
  }
  __syncthreads();
}

__device__ __forceinline__ void sincos_d(double ang, float& c, float& s) {
  const double TWO_PI = 6.283185307179586476925;
  const double n = rint(ang / TWO_PI); const double r = ang - n * TWO_PI, r2 = r * r;
  double tc = 1.0, sc = 1.0, ts = r, ss = r;
  for (int k = 1; k <= 16; ++k) { tc *= -r2 / (double)((2 * k - 1) * (2 * k)); sc += tc; ts *= -r2 / (double)((2 * k) * (2 * k + 1)); ss += ts; }
  c = (float)sc; s = (float)ss;
}
__device__ void table_phase(const Params& p, int w0) {
  const int g = blockIdx.x * NTHREADS + otid();
  if (g < 2048 * 8) {
    const int t = g >> 3, i = g & 7; float c, s;
    sincos_d((double)(t >> 6) * p.ax_inv[i], c, s); p.ropetab[t * 32 + i] = c; p.ropetab[t * 32 + 8 + i] = s;
    sincos_d((double)(t & 63) * p.ax_inv[i], c, s); p.ropetab[t * 32 + 16 + i] = c; p.ropetab[t * 32 + 24 + i] = s;
    sincos_d((double)t * p.ret_inv[i], c, s); p.rettab[t * 32 + i] = c; p.rettab[t * 32 + 16 + i] = s;
    sincos_d((double)t * p.ret_inv[i + 8], c, s); p.rettab[t * 32 + 8 + i] = c; p.rettab[t * 32 + 24 + i] = s;
  }
}

__device__ void convert_phase(const Params& p, int l, int tbeg, int tend, float* sm, int w0) {
  const int tid = otid();
  constexpr int T0 = 512, T1 = T0 + 48, T2 = T1 + 32, T3 = T2 + 32, T4 = T3 + 256, T5 = T4 + 1408, T6 = T5 + 704;
  for (int task = tbeg + blockIdx.x; task < tend; task += gridDim.x) {
    const float* src; bf16_t* dst; int K, N, Kp, nkt, tt; const float* ksc = nullptr; int mode = 0;
    if (task < T0)      { tt = task;      src = p.w_in + (long)l * 1024 * 1984; dst = p.Wt_in; K = 1024; N = 1984; Kp = 1024; nkt = 16; }
    else if (task < T1) { tt = task - T0; src = p.w_uq + (long)l * 256 * 768; dst = p.Wt_uq; K = 256; N = 768; Kp = 256; nkt = 4; ksc = p.qn_g + l * 256; }
    else if (task < T2) { tt = task - T1; src = p.w_uk + (long)l * 128 * 512; dst = p.Wt_uk; K = 128; N = 512; Kp = 256; nkt = 4; ksc = p.kvn_g + l * 128; }
    else if (task < T3) { tt = task - T2; src = p.w_uv + (long)l * 128 * 512; dst = p.Wt_uv; K = 128; N = 512; Kp = 256; nkt = 4; ksc = p.kvn_g + l * 128; }
    else if (task < T4) { tt = task - T3; src = p.w_out + (long)l * 1024 * 1024; dst = p.Wt_out; K = 1024; N = 1024; Kp = 1024; nkt = 16; }
    else if (task < T5) { tt = task - T4; src = p.ffn_up + (long)l * 1024 * 5632; dst = p.Wt_up; K = 1024; N = 5632; Kp = 1024; nkt = 16; mode = 1; }
    else                { tt = task - T5; src = p.ffn_down + (long)l * 2816 * 1024; dst = p.Wt_down; K = 2816; N = 1024; Kp = 2816; nkt = 44; }
    const int n0 = (tt / nkt) * 64, k0 = (tt % nkt) * 64;
    int c0 = n0;
    if (mode == 1) { const int pn = n0 >> 8, j = n0 & 255; c0 = j < 128 ? pn * 128 + j : 2816 + pn * 128 + (j - 128); }
    __syncthreads();
#pragma unroll
    for (int i = 0; i < 8; ++i) {
      const int kk = (tid >> 6) + 8 * i, nn = tid & 63; float v = 0.f;
      if (k0 + kk < K && n0 + nn < N) { v = src[(long)(k0 + kk) * N + c0 + nn]; if (ksc) v *= ksc[k0 + kk]; }
      sm[kk * 65 + nn] = v;
    }
    __syncthreads();
    { const int nn = tid >> 3, kk0 = (tid & 7) * 8; u32x4 w;
      w.x = pk2(sm[(kk0 + 0) * 65 + nn], sm[(kk0 + 1) * 65 + nn]); w.y = pk2(sm[(kk0 + 2) * 65 + nn], sm[(kk0 + 3) * 65 + nn]);
      w.z = pk2(sm[(kk0 + 4) * 65 + nn], sm[(kk0 + 5) * 65 + nn]); w.w = pk2(sm[(kk0 + 6) * 65 + nn], sm[(kk0 + 7) * 65 + nn]);
      *(u32x4*)(dst + (long)(n0 + nn) * Kp + k0 + kk0) = w; }
  }
  __syncthreads();
}

__device__ void ln_phase(const Params& p, int mode, int l, int w0) {
  const int tid = otid(); const int lane = tid & 63, wv = tid >> 6;
  const bool fin = (mode == 2 && l == 3);
  const int nrows = (mode == 0 || (mode == 2 && l < 3) || (mode == 1 && l < 3)) ? MTOT : NLAT;
  const float* lg = mode == 1 ? p.ln1_g + l * 1024 : p.ln2_g + l * 1024;
  const float* lb = mode == 1 ? p.ln1_b + l * 1024 : p.ln2_b + l * 1024;
  const int ml = mode == 0 ? 0 : (mode == 1 ? l : l + 1);
  const int shoff = mode == 1 ? 3072 : 0, scoff = mode == 1 ? 4096 : 1024;
  for (int rb = blockIdx.x * 16 + wv * 2; rb < nrows; rb += gridDim.x * 16) {
    f32x4 v[2][4];
#pragma unroll
    for (int u = 0; u < 2; ++u) {
      const int r = rb + u;
      const float* src = mode == 0 ? (r < NLAT ? p.x + (long)r * 1024 : p.ctx + (long)(r - NLAT) * 1024) : p.X + (long)r * 1024;
#pragma unroll
      for (int i = 0; i < 4; ++i) v[u][i] = __builtin_nontemporal_load((const f32x4*)(src + i * 256 + lane * 4));
    }
#pragma unroll
    for (int u = 0; u < 2; ++u) {
      const int r = rb + u;
      if (mode == 0) {
#pragma unroll
        for (int i = 0; i < 4; ++i) *(f32x4*)(p.X + (long)r * 1024 + i * 256 + lane * 4) = v[u][i];
      } else {
        float s = 0.f;
#pragma unroll
        for (int i = 0; i < 4; ++i) s += (v[u][i][0] + v[u][i][1]) + (v[u][i][2] + v[u][i][3]);
#pragma unroll
        for (int o = 32; o > 0; o >>= 1) s += __shfl_xor(s, o);
        const float mu = s * (1.f / 1024.f); float q = 0.f;
#pragma unroll
        for (int i = 0; i < 4; ++i) { v[u][i] = v[u][i] - mu; q += (v[u][i][0] * v[u][i][0] + v[u][i][1] * v[u][i][1]) + (v[u][i][2] * v[u][i][2] + v[u][i][3] * v[u][i][3]); }
#pragma unroll
        for (int o = 32; o > 0; o >>= 1) q += __shfl_xor(q, o);
        const float rs = rsqrtf(q * (1.f / 1024.f) + EPS);
        if (lane == 0 && !fin) { p.lnst[2 * r] = mu; p.lnst[2 * r + 1] = rs; }
#pragma unroll
        for (int i = 0; i < 4; ++i) { const f32x4 g = *(const f32x4*)(lg + i * 256 + lane * 4), bb = *(const f32x4*)(lb + i * 256 + lane * 4); v[u][i] = v[u][i] * rs * g + bb; }
      }
      if (fin) {
#pragma unroll
        for (int i = 0; i < 4; ++i) *(f32x4*)(p.out + (long)r * 1024 + i * 256 + lane * 4) = v[u][i];
      } else {
        const float* mb = p.mod + ((long)ml * 33 + row_bi(r)) * 6144;
#pragma unroll
        for (int i = 0; i < 4; ++i) {
          const f32x4 sh = *(const f32x4*)(mb + shoff + i * 256 + lane * 4), sc = *(const f32x4*)(mb + scoff + i * 256 + lane * 4);
          const f32x4 h = v[u][i] * (sc + 1.f) + sh;
          u32x2 w; w.x = pk2(h[0], h[1]); w.y = pk2(h[2], h[3]);
          *(u32x2*)(p.H + (long)r * 1024 + i * 256 + lane * 4) = w;
          if (mode == 1 && ((r & 255) == 0 || (r & 255) == 255)) *(u32x2*)(p.HA + (long)((r >> 8) * 2 + ((r & 255) == 255)) * 1024 + i * 256 + lane * 4) = w;
        }
      }
    }
  }
}

__device__ void mlaprep_phase(const Params& p, int w0) {
  const int tid = otid(); const int lane = tid & 63, wv = tid >> 6;
  for (int r = blockIdx.x * 8 + wv; r < MTOT; r += gridDim.x * 8) {
    const bf16_t* pr = p.P + (long)r * DIN;
    const u32x2 cq = *(const u32x2*)(pr + MCQ + lane * 4);
    const unsigned ck = *(const unsigned*)(pr + MCKV + lane * 2);
    float sq = bflo(cq.x) * bflo(cq.x) + bfhi(cq.x) * bfhi(cq.x) + bflo(cq.y) * bflo(cq.y) + bfhi(cq.y) * bfhi(cq.y);
    float sk = bflo(ck) * bflo(ck) + bfhi(ck) * bfhi(ck);
#pragma unroll
    for (int o = 32; o > 0; o >>= 1) { sq += __shfl_xor(sq, o); sk += __shfl_xor(sk, o); }
    if (lane == 0) { p.rstd[2 * r] = rsqrtf(sq * (1.f / 256.f) + EPS); p.rstd[2 * r + 1] = rsqrtf(sk * (1.f / 128.f) + EPS); }
    const float kv = bf2f(pr[MKR + (lane & 31)]);
    float outv = kv; int b, key;
    if (r < NLAT) {
      b = r >> 11; key = r & 2047;
      const float other = __shfl_xor(kv, 8);
      const int i = lane & 7, part = (lane >> 4) & 1;
      const float cs = p.ropetab[key * 32 + part * 16 + i], sn = p.ropetab[key * 32 + part * 16 + 8 + i];
      outv = (lane & 8) ? (other * sn + kv * cs) : (kv * cs - other * sn);
    } else { b = (r - NLAT) >> 8; key = 2048 + ((r - NLAT) & 255); }
    if (lane < 32) p.Kr[((long)b * 2304 + key) * 32 + lane] = f2bf(outv);
  }
}

constexpr int SSTR = 72;
__device__ __forceinline__ int chunk_row0(int b, int c) { return c < 4 ? NLAT + b * 256 + c * 64 : b * 2048 + (c - 4) * 64; }
__device__ __forceinline__ f32x4 mma16(const bf16_t* A, const bf16_t* B, f32x4 acc, int fr, int fq) {
  const bf16x8 a = *(const bf16x8*)(A + fr * SSTR + fq * 8), b = *(const bf16x8*)(B + fr * SSTR + fq * 8);
  return __builtin_amdgcn_mfma_f32_16x16x32_bf16(a, b, acc, 0, 0, 0);
}

__device__ __forceinline__ long state_idx(int mx, int b, int h, int dir, int c) { return ((((long)(mx * 32 + b) * 4 + h) * 2 + dir) * 36 + c); }

struct ScanPre { u32x2 kw, qw, kp, qp, lw; u32x4 vw, gw; f32x4 cs, sn; float w[16]; float bias; u32x4 st; };

template <bool C>
__device__ __forceinline__ void scan_fetch(const Params& p, int l, int task, int tid, ScanPre& R) {
  const int c = task % 36, h = (task / 36) & 3, b = (task / 144) & 31, mx = task / 4608;
  const int row0 = chunk_row0(b, c);
  const int qoff = (mx ? RQ : GQ) + h * 32, koff = (mx ? RK : GK) + h * 32, voff = (mx ? RV : GV) + h * 64;
  const int s = tid >> 3, d0 = (tid & 7) * 4;
  const bf16_t* pr = p.P + (long)(row0 + s) * DIN;
  R.kw = *(const u32x2*)(pr + koff + d0);
  if (C) R.qw = *(const u32x2*)(pr + qoff + d0);
  if (mx == 1 && c >= 4) {
    const int dp = d0 ^ 16, i0 = d0 & 15, t = (c - 4) * 64 + s;
    R.kp = *(const u32x2*)(pr + koff + dp);
    if (C) R.qp = *(const u32x2*)(pr + qoff + dp);
    R.cs = *(const f32x4*)(p.rettab + t * 32 + i0); R.sn = *(const f32x4*)(p.rettab + t * 32 + 16 + i0);
  }
  R.vw = *(const u32x4*)(pr + voff + (tid & 7) * 8);
  const int gd = tid & 31, gdir = (tid >> 5) & 1;
  if (mx == 0) {
    R.lw = *(const u32x2*)(pr + GLR + d0);
#pragma unroll
    for (int r = 0; r < 16; ++r) R.w[r] = p.gate_w[(((long)l * 2 + gdir) * 16 + r) * 128 + h * 32 + gd];
    R.bias = p.gate_b[((long)l * 2 + gdir) * 128 + h * 32 + gd];
  } else R.bias = p.ret_decay[((long)l * 2 + gdir) * 4 + h];
  if (C) {
    R.gw = *(const u32x4*)(pr + (mx ? RG : GG) + h * 64 + (tid & 7) * 8);
    R.st = *(const u32x4*)(p.St + state_idx(mx, b, h, tid >> 8, c) * 2048 + (tid & 255) * 8);
  }
}

template <bool C>
__device__ __forceinline__ void scan_stage1(const ScanPre& R, int mx, int c, int tid, float* lrs, bf16_t* VT, float (&kv)[4], float (&qv)[4]) {
  const int s = tid >> 3, d0 = (tid & 7) * 4;
  kv[0] = bflo(R.kw.x); kv[1] = bfhi(R.kw.x); kv[2] = bflo(R.kw.y); kv[3] = bfhi(R.kw.y);
  qv[0] = qv[1] = qv[2] = qv[3] = 0.f;
  if (C) { qv[0] = bflo(R.qw.x); qv[1] = bfhi(R.qw.x); qv[2] = bflo(R.qw.y); qv[3] = bfhi(R.qw.y); }
  if (mx == 1 && c >= 4) {
    const float kpv[4] = {bflo(R.kp.x), bfhi(R.kp.x), bflo(R.kp.y), bfhi(R.kp.y)};
    float qpv[4] = {0.f, 0.f, 0.f, 0.f};
    if (C) { qpv[0] = bflo(R.qp.x); qpv[1] = bfhi(R.qp.x); qpv[2] = bflo(R.qp.y); qpv[3] = bfhi(R.qp.y); }
#pragma unroll
    for (int j = 0; j < 4; ++j) {
      const float cs = R.cs[j], sn = R.sn[j];
      if (d0 < 16) { kv[j] = kv[j] * cs - kpv[j] * sn; qv[j] = qv[j] * cs - qpv[j] * sn; }
      else         { kv[j] = kpv[j] * sn + kv[j] * cs; qv[j] = qpv[j] * sn + qv[j] * cs; }
    }
  }
  const int e0 = (tid & 7) * 8;
#pragma unroll
  for (int j = 0; j < 4; ++j) { VT[(e0 + 2 * j) * SSTR + s] = (bf16_t)(R.vw[j] & 0xffffu); VT[(e0 + 2 * j + 1) * SSTR + s] = (bf16_t)(R.vw[j] >> 16); }
  if (mx == 0) { *(f32x4*)(lrs + s * 32 + d0) = (f32x4){bflo(R.lw.x), bfhi(R.lw.x), bflo(R.lw.y), bfhi(R.lw.y)}; }
}

__device__ __forceinline__ void scan_stage2(const ScanPre& R, int mx, int tid, const float* lrs, float* tot, float (&a)[8]) {
  const int d = tid & 31, dir = (tid >> 5) & 1, sg = tid >> 6;
  if (mx == 0) {
#pragma unroll
    for (int j = 0; j < 8; ++j) {
      float z = R.bias;
#pragma unroll
      for (int r = 0; r < 16; r += 4) { const f32x4 lv = *(const f32x4*)(lrs + (sg * 8 + j) * 32 + dir * 16 + r); z += lv[0] * R.w[r] + lv[1] * R.w[r + 1] + lv[2] * R.w[r + 2] + lv[3] * R.w[r + 3]; }
      a[j] = logsigmoid_f(z) * (1.f / 16.f);
    }
  } else {
    const float lg = logsigmoid_f(R.bias);
#pragma unroll
    for (int j = 0; j < 8; ++j) a[j] = lg;
  }
  if (dir == 0) {
#pragma unroll
    for (int j = 1; j < 8; ++j) a[j] += a[j - 1];
  } else {
#pragma unroll
    for (int j = 6; j >= 0; --j) a[j] += a[j + 1];
  }
  tot[sg * 64 + dir * 32 + d] = dir == 0 ? a[7] : a[0];
}
__device__ __forceinline__ void scan_stage3(int tid, const float* tot, float* bc, const float (&a)[8]) {
  const int d = tid & 31, dir = (tid >> 5) & 1, sg = tid >> 6;
  float off = 0.f;
#pragma unroll
  for (int g = 0; g < 8; ++g) { const float tv = tot[g * 64 + dir * 32 + d]; if (dir == 0 ? (g < sg) : (g > sg)) off += tv; }
#pragma unroll
  for (int j = 0; j < 8; ++j) bc[(dir * 64 + sg * 8 + j) * 32 + d] = a[j] + off;
}

__device__ void scanA_phase(const Params& p, int l, char* shm, int w0) {
  float* bc = (float*)shm; float* lrs = bc + 4096; float* tot = lrs + 2048;
  bf16_t* VT = (bf16_t*)(tot + 512); bf16_t* KHT = VT + 64 * SSTR;
  const int tid = otid(), wv = tid >> 6, lane = tid & 63, fr = lane & 15, fq = lane >> 4;
  const int NT = 2 * 32 * 4 * 36;
  ScanPre R;
  int task = blockIdx.x;
  if (task < NT) scan_fetch<false>(p, l, task, tid, R);
  for (; task < NT; task += gridDim.x) {
    const int c = task % 36, h = (task / 36) & 3, b = (task / 144) & 31, mx = task / 4608;
    float kv[4], qv[4], a[8];
    __syncthreads();
    scan_stage1<false>(R, mx, c, tid, lrs, VT, kv, qv);
    __syncthreads();
    scan_stage2(R, mx, tid, lrs, tot, a);
    if (task + (int)gridDim.x < NT) scan_fetch<false>(p, l, task + gridDim.x, tid, R);
    __syncthreads();
    scan_stage3(tid, tot, bc, a);
    __syncthreads();
    { const int s = tid >> 3, d0 = (tid & 7) * 4;
#pragma unroll
      for (int dir = 0; dir < 2; ++dir) {
        const f32x4 bv = *(const f32x4*)(bc + (dir * 64 + s) * 32 + d0), be = *(const f32x4*)(bc + (dir * 64 + (dir ? 0 : 63)) * 32 + d0);
#pragma unroll
        for (int j = 0; j < 4; ++j) KHT[(dir * 32 + d0 + j) * SSTR + s] = f2bf(kv[j] * __expf(be[j] - bv[j]));
      }
      if (tid < 64) { const int d = tid & 31, dir = tid >> 5; p.dec[state_idx(mx, b, h, dir, c) * 32 + d] = __expf(bc[(dir * 64 + (dir ? 0 : 63)) * 32 + d]); }
    }
    __syncthreads();
#pragma unroll
    for (int q = 0; q < 2; ++q) {
      const int id = wv * 2 + q, dir = id >> 3, dti = (id >> 2) & 1, eti = id & 3;
      f32x4 acc = {0.f, 0.f, 0.f, 0.f};
#pragma unroll
      for (int ks = 0; ks < 2; ++ks) acc = mma16(KHT + (dir * 32 + dti * 16) * SSTR + ks * 32, VT + (eti * 16) * SSTR + ks * 32, acc, fr, fq);
      asm volatile("s_nop 15\n\ts_nop 15" : "+v"(acc[0]), "+v"(acc[1]), "+v"(acc[2]), "+v"(acc[3]));
      u32x2 wst; wst.x = pk2(acc[0], acc[1]); wst.y = pk2(acc[2], acc[3]);
      *(u32x2*)(p.St + state_idx(mx, b, h, dir, c) * 2048 + (eti * 16 + fr) * 32 + dti * 16 + fq * 4) = wst;
    }
  }
  __syncthreads();
}

__device__ void scanB_phase(const Params& p, int w0) {
  const int tid = otid();
  for (int task = blockIdx.x; task < 512 * 2; task += gridDim.x) {
    const int chain = task >> 1, i = ((task & 1) * 512 + tid) * 2, d = i & 31, dir = chain & 1;
    bf16_t* st = p.St + (long)chain * 36 * 2048 + i; const float* dc = p.dec + (long)chain * 36 * 32 + d;
    unsigned loc[36]; float dv0[36], dv1[36];
#pragma unroll
    for (int k = 0; k < 36; ++k) { const int c = dir == 0 ? k : (k < 4 ? 3 - k : 39 - k); loc[k] = *(const unsigned*)(st + (long)c * 2048); dv0[k] = dc[c * 32]; dv1[k] = dc[c * 32 + 1]; }
    float r0 = 0.f, r1 = 0.f;
#pragma unroll
    for (int k = 0; k < 36; ++k) { const int c = dir == 0 ? k : (k < 4 ? 3 - k : 39 - k); *(unsigned*)(st + (long)c * 2048) = pk2(r0, r1); r0 = r0 * dv0[k] + bflo(loc[k]); r1 = r1 * dv1[k] + bfhi(loc[k]); }
  }
}

__device__ void scanC_phase(const Params& p, int l, bool last, char* shm, int w0) {
  float* bc = (float*)shm; float* lrs = bc + 4096; float* tot = lrs + 2048;
  bf16_t* VT = (bf16_t*)(tot + 512); bf16_t* QFB = VT + 64 * SSTR; bf16_t* KFB = QFB + 64 * SSTR; bf16_t* ST = KFB + 64 * SSTR; bf16_t* ATT = ST + 64 * SSTR;
  float* O = (float*)(ATT + 64 * SSTR);
  const int tid = otid(), wv = tid >> 6, lane = tid & 63, fr = lane & 15, fq = lane >> 4;
  const float qscale = 0.17677669529663687f;
  const int NT = 2 * 32 * 4 * 36, G = gridDim.x;
  auto nextt = [&](int t) { t += G; while (last && t < NT && (t % 36) < 4) t += G; return t; };
  ScanPre R;
  int task = (int)blockIdx.x - G; task = nextt(task);
  if (task < NT) scan_fetch<true>(p, l, task, tid, R);
  for (; task < NT;) {
    const int c = task % 36, h = (task / 36) & 3, b = (task / 144) & 31, mx = task / 4608;
    const int ntask = nextt(task);
    float kv[4], qv[4], a[8];
    __syncthreads();
    scan_stage1<true>(R, mx, c, tid, lrs, VT, kv, qv);
    { const int idx = (tid & 255) * 8; *(u32x4*)(ST + (idx >> 5) * SSTR + (tid >> 8) * 32 + (idx & 31)) = R.st; }
    const u32x4 gw = R.gw;
    __syncthreads();
    scan_stage2(R, mx, tid, lrs, tot, a);
    if (ntask < NT) scan_fetch<true>(p, l, ntask, tid, R);
    __syncthreads();
    scan_stage3(tid, tot, bc, a);
    __syncthreads();
    { const int s = tid >> 3, d0 = (tid & 7) * 4;
#pragma unroll
      for (int dir = 0; dir < 2; ++dir) {
        const f32x4 bv = *(const f32x4*)(bc + (dir * 64 + s) * 32 + d0);
        float qx[4], kx[4];
#pragma unroll
        for (int j = 0; j < 4; ++j) { qx[j] = qv[j] * qscale * __expf(bv[j]); kx[j] = kv[j] * __expf(-bv[j]); }
        u32x2 wq, wk; wq.x = pk2(qx[0], qx[1]); wq.y = pk2(qx[2], qx[3]); wk.x = pk2(kx[0], kx[1]); wk.y = pk2(kx[2], kx[3]);
        *(u32x2*)(QFB + s * SSTR + dir * 32 + d0) = wq; *(u32x2*)(KFB + s * SSTR + dir * 32 + d0) = wk;
      }
    }
    __syncthreads();
#pragma unroll
    for (int q = 0; q < 2; ++q) {
      const int id = wv * 2 + q, tt = id >> 2, ts = id & 3;
      f32x4 af = {0.f, 0.f, 0.f, 0.f}, ab = {0.f, 0.f, 0.f, 0.f};
      if (ts <= tt) af = mma16(QFB + tt * 16 * SSTR, KFB + ts * 16 * SSTR, af, fr, fq);
      if (ts >= tt) ab = mma16(QFB + tt * 16 * SSTR + 32, KFB + ts * 16 * SSTR + 32, ab, fr, fq);
#pragma unroll
      for (int j = 0; j < 4; ++j) {
        const int t = tt * 16 + fq * 4 + j, s = ts * 16 + fr;
        const float v = (s <= t ? af[j] : 0.f) + (s >= t ? ab[j] : 0.f);
        ATT[t * SSTR + s] = f2bf(v);
      }
    }
    __syncthreads();
#pragma unroll
    for (int q = 0; q < 2; ++q) {
      const int id = wv * 2 + q, tt = id >> 2, et = id & 3;
      f32x4 acc = {0.f, 0.f, 0.f, 0.f};
#pragma unroll
      for (int ks = 0; ks < 2; ++ks) {
        acc = mma16(ATT + tt * 16 * SSTR + ks * 32, VT + et * 16 * SSTR + ks * 32, acc, fr, fq);
        acc = mma16(QFB + tt * 16 * SSTR + ks * 32, ST + et * 16 * SSTR + ks * 32, acc, fr, fq);
      }
#pragma unroll
      for (int j = 0; j < 4; ++j) O[(tt * 16 + fq * 4 + j) * 65 + et * 16 + fr] = acc[j];
    }
    __syncthreads();
    { const int t = tid >> 3, e0 = (tid & 7) * 8; float o[8]; float s = 0.f;
#pragma unroll
      for (int j = 0; j < 8; ++j) { o[j] = O[t * 65 + e0 + j]; s += o[j]; }
      s += __shfl_xor(s, 1); s += __shfl_xor(s, 2); s += __shfl_xor(s, 4);
      const float mu = mx == 1 ? s * (1.f / 64.f) : 0.f; float qq = 0.f;
#pragma unroll
      for (int j = 0; j < 8; ++j) { o[j] -= mu; qq += o[j] * o[j]; }
      qq += __shfl_xor(qq, 1); qq += __shfl_xor(qq, 2); qq += __shfl_xor(qq, 4);
      const float rs = rsqrtf(qq * (1.f / 64.f) + EPS);
      const int row = chunk_row0(b, c) + t;
      float r[8];
#pragma unroll
      for (int j = 0; j < 8; ++j) {
        const unsigned w = gw[j >> 1]; const float gt = (j & 1) ? bfhi(w) : bflo(w);
        float y = o[j] * rs; if (mx == 0) y *= p.gla_g[l * 64 + e0 + j];
        r[j] = y * silu_f(gt);
      }
      u32x4 w; w.x = pk2(r[0], r[1]); w.y = pk2(r[2], r[3]); w.z = pk2(r[4], r[5]); w.w = pk2(r[6], r[7]);
      *(u32x4*)(p.H + (long)row * 1024 + mx * 256 + h * 64 + e0) = w;
    }
    task = ntask;
  }
  __syncthreads();
}

constexpr int KSTR = 104, VSTR = 72;
__device__ void attn_phase(const Params& p, bool last, char* shm, int w0) {
  bf16_t* Ks = (bf16_t*)shm;
  bf16_t* Vs = Ks + 2 * 64 * KSTR;
  const int tid = otid(), wv = tid >> 6, lane = tid & 63, lq = lane & 31, hb = lane >> 5;
  const int ntask = 1024 + (last ? 0 : 256);
  for (int task = blockIdx.x; task < ntask; task += gridDim.x) {
    int b, h, qrow0, nkeys, key0, nwav;
    if (task < 1024) { b = task >> 5; h = (task >> 2) & 7; qrow0 = b * 2048 + (task & 3) * 512; nkeys = 2304; key0 = 0; nwav = 8; }
    else { const int t = task - 1024; b = t >> 3; h = t & 7; qrow0 = NLAT + b * 256; nkeys = 256; key0 = 2048; nwav = 4; }
    const bool act = wv < nwav;
    bf16x8 qf[2][6];
    if (act) {
#pragma unroll
      for (int qt = 0; qt < 2; ++qt) {
        const int row = qrow0 + wv * 64 + qt * 32 + lq; const bf16_t* qp = p.Q + (long)row * 768 + h * 96;
#pragma unroll
        for (int ks = 0; ks < 4; ++ks) qf[qt][ks] = *(const bf16x8*)(qp + ks * 16 + hb * 8);
#pragma unroll
        for (int ks = 4; ks < 6; ++ks) {
          const bf16x8 own = *(const bf16x8*)(qp + ks * 16 + hb * 8);
          if (task < 1024) {
            const bf16x8 oth = *(const bf16x8*)(qp + ks * 16 + (hb ^ 1) * 8);
            const int t = row & 2047; const float* tb = p.ropetab + t * 32 + (ks - 4) * 16;
            bf16x8 r;
#pragma unroll
            for (int i = 0; i < 8; i += 2) {
              const float cs0 = tb[i], sn0 = tb[8 + i], cs1 = tb[i + 1], sn1 = tb[9 + i];
              const float o0 = bf2f((bf16_t)own[i]), o1 = bf2f((bf16_t)own[i + 1]), x0 = bf2f((bf16_t)oth[i]), x1 = bf2f((bf16_t)oth[i + 1]);
              const float r0 = hb ? (x0 * sn0 + o0 * cs0) : (o0 * cs0 - x0 * sn0);
              const float r1 = hb ? (x1 * sn1 + o1 * cs1) : (o1 * cs1 - x1 * sn1);
              const unsigned w = pk2(r0, r1); r[i] = (short)(w & 0xffffu); r[i + 1] = (short)(w >> 16);
            }
            qf[qt][ks] = r;
          } else qf[qt][ks] = own;
        }
      }
    }
    f32x16 ot[2][2];
#pragma unroll
    for (int i = 0; i < 2; ++i)
#pragma unroll
      for (int j = 0; j < 2; ++j)
#pragma unroll
        for (int e = 0; e < 16; ++e) ot[i][j][e] = 0.f;
    float mrun[2] = {0.f, 0.f}, lrun[2] = {0.f, 0.f};
    const bf16_t* Kng = p.Kn + ((long)(b * 8 + h) * 2304 + key0) * 64;
    const bf16_t* Krg = p.Kr + ((long)b * 2304 + key0) * 32;
    const bf16_t* Vtg = p.Vt + ((long)(b * 8 + h) * 64) * 2304 + key0;
    const unsigned offk = (unsigned)tid * 16u, offr = (unsigned)(tid & 255) * 16u, offv = (unsigned)((tid >> 3) * 2304 + (tid & 7) * 8) * 2u;
    const int lk0 = (tid >> 3) * KSTR + (tid & 7) * 8, lk1 = ((tid & 255) >> 2) * KSTR + 64 + (tid & 3) * 8, lv = (tid >> 3) * VSTR + (tid & 7) * 8;
    u32x4 rk0, rk1 = {0, 0, 0, 0}, rv;
    auto gload = [&](int kt) {
      rk0 = *(const u32x4*)((const char*)Kng + (size_t)kt * 8192 + offk);
      if (tid < 256) rk1 = *(const u32x4*)((const char*)Krg + (size_t)kt * 4096 + offr);
      rv = *(const u32x4*)((const char*)Vtg + (size_t)kt * 128 + offv);
    };
    auto lstore = [&](int buf) {
      *(u32x4*)(Ks + buf * 64 * KSTR + lk0) = rk0;
      if (tid < 256) *(u32x4*)(Ks + buf * 64 * KSTR + lk1) = rk1;
      *(u32x4*)(Vs + buf * 64 * VSTR + lv) = rv;
    };
    const int ntile = nkeys / 64;
    __syncthreads();
    gload(0); lstore(0);
    __syncthreads();
    for (int kt = 0; kt < ntile; ++kt) {
      const int buf = kt & 1;
      if (kt + 1 < ntile) gload(kt + 1);
      if (act) {
        const bf16_t* Kb = Ks + buf * 64 * KSTR; const bf16_t* Vb = Vs + buf * 64 * VSTR;
#pragma unroll
        for (int k2 = 0; k2 < 2; ++k2) {
          f32x16 st[2];
#pragma unroll
          for (int j = 0; j < 2; ++j)
#pragma unroll
            for (int e = 0; e < 16; ++e) st[j][e] = -mrun[j];
#pragma unroll
          for (int ks = 0; ks < 6; ++ks) {
            const bf16x8 kf = *(const bf16x8*)(Kb + (k2 * 32 + lq) * KSTR + ks * 16 + hb * 8);
            st[0] = __builtin_amdgcn_mfma_f32_32x32x16_bf16(kf, qf[0][ks], st[0], 0, 0, 0);
            st[1] = __builtin_amdgcn_mfma_f32_32x32x16_bf16(kf, qf[1][ks], st[1], 0, 0, 0);
          }
          bf16x8 pf[2][2];
#pragma unroll
          for (int qt = 0; qt < 2; ++qt) {
            float mx = st[qt][0];
#pragma unroll
            for (int e = 1; e < 16; ++e) mx = fmaxf(mx, st[qt][e]);
            mx = fmaxf(mx, __shfl_xor(mx, 32));
            const bool first = (kt == 0 && k2 == 0);
            if (first || __builtin_amdgcn_ballot_w64(mx > 6.f) != 0ull) {
              const float delta = first ? mx : fmaxf(mx, 0.f);
              const float alpha = first ? 1.f : __builtin_amdgcn_exp2f(-delta);
              mrun[qt] += delta;
#pragma unroll
              for (int e = 0; e < 16; ++e) st[qt][e] -= delta;
              lrun[qt] *= alpha;
#pragma unroll
              for (int dt = 0; dt < 2; ++dt)
#pragma unroll
                for (int e = 0; e < 16; ++e) ot[dt][qt][e] *= alpha;
            }
            float ls = 0.f;
#pragma unroll
            for (int s2 = 0; s2 < 2; ++s2) {
              const int g0 = s2 * 2; bf16x8 f;
#pragma unroll
              for (int j = 0; j < 4; j += 2) {
                const float p0 = __builtin_amdgcn_exp2f(st[qt][g0 * 4 + j]), p1 = __builtin_amdgcn_exp2f(st[qt][g0 * 4 + j + 1]);
                const float p2 = __builtin_amdgcn_exp2f(st[qt][(g0 + 1) * 4 + j]), p3 = __builtin_amdgcn_exp2f(st[qt][(g0 + 1) * 4 + j + 1]);
                ls += (p0 + p1) + (p2 + p3);
                const unsigned ww0 = pk2(p0, p1), ww1 = pk2(p2, p3);
                f[j] = (short)(ww0 & 0xffffu); f[j + 1] = (short)(ww0 >> 16); f[4 + j] = (short)(ww1 & 0xffffu); f[4 + j + 1] = (short)(ww1 >> 16);
              }
              pf[qt][s2] = f;
            }
            lrun[qt] += ls;
          }
#pragma unroll
          for (int dt = 0; dt < 2; ++dt)
#pragma unroll
            for (int s2 = 0; s2 < 2; ++s2) {
              const bf16_t* vp = Vb + (dt * 32 + lq) * VSTR + (k2 * 2 + s2) * 16 + hb * 4;
              const bf16x4 v0 = *(const bf16x4*)vp, v1 = *(const bf16x4*)(vp + 8);
              bf16x8 vf; vf[0] = v0[0]; vf[1] = v0[1]; vf[2] = v0[2]; vf[3] = v0[3]; vf[4] = v1[0]; vf[5] = v1[1]; vf[6] = v1[2]; vf[7] = v1[3];
              ot[dt][0] = __builtin_amdgcn_mfma_f32_32x32x16_bf16(vf, pf[0][s2], ot[dt][0], 0, 0, 0);
              ot[dt][1] = __builtin_amdgcn_mfma_f32_32x32x16_bf16(vf, pf[1][s2], ot[dt][1], 0, 0, 0);
            }
        }
      }
      if (kt + 1 < ntile) lstore(buf ^ 1);
      __syncthreads();
    }
    if (act) {
#pragma unroll
      for (int qt = 0; qt < 2; ++qt) {
        const float lt = lrun[qt] + __shfl_xor(lrun[qt], 32); const float inv = 1.f / lt;
        const int row = qrow0 + wv * 64 + qt * 32 + lq; bf16_t* op = p.H + (long)row * 1024 + 512 + h * 64;
#pragma unroll
        for (int dt = 0; dt < 2; ++dt)
#pragma unroll
          for (int g = 0; g < 4; ++g) {
            u32x2 w; w.x = pk2(ot[dt][qt][g * 4] * inv, ot[dt][qt][g * 4 + 1] * inv); w.y = pk2(ot[dt][qt][g * 4 + 2] * inv, ot[dt][qt][g * 4 + 3] * inv);
            *(u32x2*)(op + dt * 32 + g * 8 + hb * 4) = w;
          }
      }
    }
  }
  __syncthreads();
}

#define XB_TMO      128
#define XB_XCNT(j)  (256  + 64 * (j))
#define XB_XSUB(j)  (1280 + 64 * (j))
#define XB_XGEN(j)  (2304 + 64 * (j))
#define XB_TOP      3328
#define XB_TOPGEN   3392
#define XCD_BAR_WORDS 3456
#define XB_SPIN_CAP (1u << 18)
#define LAS __attribute__((address_space(3)))
__device__ __forceinline__ unsigned xb_ld(unsigned* p)              { return __hip_atomic_load(p, __ATOMIC_RELAXED, __HIP_MEMORY_SCOPE_AGENT); }
__device__ __forceinline__ unsigned xb_add(unsigned* p, unsigned v) { return __hip_atomic_fetch_add(p, v, __ATOMIC_RELAXED, __HIP_MEMORY_SCOPE_AGENT); }
__device__ __forceinline__ unsigned xb_xcc_id() { return (unsigned)__builtin_amdgcn_s_getreg((3 << 11) | 20) & 0xFu; }
#define XB_SPIN(cond, bar) do { unsigned _sp = 0; while (cond) { __builtin_amdgcn_s_sleep(1); \
    if ((++_sp & 255u) == 0u) { if (xb_ld(&(bar)[XB_TMO])) break; if (_sp > XB_SPIN_CAP) { atomicAdd(&(bar)[XB_TMO], 1u); break; } } } } while (0)
struct XcdBarrier { unsigned* bar; unsigned x; volatile LAS unsigned* st; };
__device__ __forceinline__ XcdBarrier xcd_barrier_post(unsigned* bar, volatile LAS unsigned* st, int tid) {
  XcdBarrier b; b.bar = bar; b.x = xb_xcc_id(); b.st = st;
  if (tid == 0) (void)xb_add(&bar[XB_XCNT(b.x)], 1u);
  return b;
}
__device__ __forceinline__ void xcd_barrier_complete(unsigned* bar, unsigned x, unsigned& nloc, unsigned& nx) {
  const unsigned G = gridDim.x * gridDim.y * gridDim.z;
  unsigned sum, cnt, mine, sp = 0u;
  for (;;) {
    sum = 0u; cnt = 0u; mine = 0u;
#pragma unroll
    for (unsigned j = 0; j < 16; ++j) { const unsigned c = xb_ld(&bar[XB_XCNT(j)]); sum += c; cnt += (c > 0u) ? 1u : 0u; mine = (j == x) ? c : mine; }
    if (sum == G) break;
    __builtin_amdgcn_s_sleep(1);
    if ((++sp & 255u) == 0u) { if (xb_ld(&bar[XB_TMO])) break; if (sp > XB_SPIN_CAP) { atomicAdd(&bar[XB_TMO], 1u); break; } }
  }
  nloc = mine > 0u ? mine : 1u; nx = cnt > 0u ? cnt : 1u;
}
__device__ __forceinline__ void xcd_barrier(unsigned* bar_, volatile LAS unsigned* st_, int tid) {
  XcdBarrier b; b.bar = bar_; b.st = st_; b.x = xb_xcc_id();
  asm volatile("s_waitcnt vmcnt(0)" ::: "memory");
  __syncthreads();
  if (tid == 0) {
    unsigned* bar = b.bar;
    __builtin_amdgcn_s_waitcnt(0);
    unsigned nloc = b.st[0], nx = b.st[1];
    if (nloc == 0u) { xcd_barrier_complete(bar, b.x, nloc, nx); b.st[0] = nloc; b.st[1] = nx; }
    const unsigned old = xb_add(&bar[XB_XSUB(b.x)], 1u);
    const unsigned gen = old / nloc;
    if (old + 1u == (gen + 1u) * nloc) {
      __builtin_amdgcn_fence(__ATOMIC_RELEASE, "agent");
      asm volatile("s_waitcnt vmcnt(0)" ::: "memory");
      const unsigned og = xb_add(&bar[XB_TOP], 1u);
      const unsigned tg = og / nx;
      if (og + 1u == (tg + 1u) * nx) xb_add(&bar[XB_TOPGEN], 1u);
      else XB_SPIN(xb_ld(&bar[XB_TOPGEN]) == tg, bar);
      __builtin_amdgcn_fence(__ATOMIC_ACQUIRE, "agent");
      xb_add(&bar[XB_XGEN(b.x)], 1u);
      asm volatile("s_waitcnt vmcnt(0)" ::: "memory");
    } else {
      XB_SPIN(xb_ld(&bar[XB_XGEN(b.x)]) == gen, bar);
      __builtin_amdgcn_fence(__ATOMIC_ACQUIRE, "agent");
      asm volatile("s_waitcnt vmcnt(0)" ::: "memory");
    }
  }
  __syncthreads();
}

__device__ void run_phase(const Params& p, int ph, char* shm, int w0) {
  if (ph == 0) { mod_phase(p, (float*)shm, w0); table_phase(p, w0); convert_phase(p, 0, 0, 2992, (float*)shm, w0); return; }
  if (ph == 1) { ln_phase(p, 0, 0, w0); return; }
  const int l = (ph - 2) / NPL, s = (ph - 2) % NPL; const bool last = (l == 3);
  const float* modl = p.mod + (long)l * 33 * 6144;
  bf16_t* sh = (bf16_t*)shm;
  switch (s) {
    case 0: { EpiP e{p.P}; gemm_phase<true>(p.H, 1024, p.Wt_in, 1024, MTOT / 256, 8, 1024, e, sh, w0); } break;
    case 1: scanA_phase(p, l, shm, w0); mlaprep_phase(p, w0); if (l > 0) convert_phase(p, l, 2288, 2992, (float*)shm, w0); break;
    case 2: { scanB_phase(p, w0); EpiVt e{p.Vt, p.rstd}; gemm_phase<true>(p.Wt_uv, 256, p.P + MCKV, DIN, 2, MTOT / 256, 128, e, sh, w0); } break;
    case 3: scanC_phase(p, l, last, shm, w0); break;
    case 4: { EpiQ e{p.Q, p.rstd}; gemm_phase<true>(p.P + MCQ, DIN, p.Wt_uq, 256, (last ? NLAT : MTOT) / 256, 3, 256, e, sh, w0);
              EpiK e2{p.Kn, p.rstd}; gemm_phase<true>(p.P + MCKV, DIN, p.Wt_uk, 256, MTOT / 256, 2, 128, e2, sh, w0); } break;
    case 5: attn_phase(p, last, shm, w0); break;
    case 6: { EpiResLN e{p, l, 0}; gemm_phase<true, true>(p.H, 1024, p.Wt_out, 1024, (last ? NLAT : MTOT) / 256, 4, 1024, e, sh, w0); } break;
    case 7: { EpiU e{p.HU}; gemm_phase<true>(p.HA, 1024, p.Wt_up, 1024, 3, 22, 1024, e, sh, w0);
              if (!last) convert_phase(p, l + 1, 0, 880, (float*)shm, w0); } break;
    case 8: { EpiConv e{p.ACT, p.HU, p.conv_w + (long)l * 3 * 5632, p.conv_b + (long)l * 5632}; gemm_phase<false>(p.H, 1024, p.Wt_up, 1024, (last ? NLAT : MTOT) / 256, 22, 1024, e, sh, w0); } break;
    case 9: { EpiResLN e{p, l, 1}; gemm_phase<true, true>(p.ACT, DFF, p.Wt_down, DFF, (last ? NLAT : MTOT) / 256, 4, DFF, e, sh, w0);
              if (!last) convert_phase(p, l + 1, 880, 2288, (float*)shm, w0); } break;
  }
}

__global__ void __launch_bounds__(NTHREADS) mk(Params p, int ph0, int ph1) {
  extern __shared__ __attribute__((aligned(16))) char shm[];
  __shared__ uint4 xb_words;
  cg::grid_group grid = cg::this_grid();
  const int w0 = __builtin_amdgcn_readfirstlane((int)(threadIdx.x >> 6));
  {
    const int tid = otid();
    if (tid == 0) xb_words = make_uint4(0u, 0u, 0u, 0u);
    __syncthreads();
  }
  { const int tid = otid(); (void)xcd_barrier_post(p.bar, (volatile LAS unsigned*)&xb_words, tid); }
  if (ph1 < 0) grid.sync();
  for (int ph = ph0; ph < ph1; ++ph) {
    run_phase(p, ph, shm, w0);
    if (ph + 1 < ph1) {
      { const int tid = otid(); xcd_barrier(p.bar, (volatile LAS unsigned*)&xb_words, tid); }
    }
  }
}

extern "C" void kernel_launch(void* const* d_in, const int* in_sizes, int n_in, void* d_out, int out_size, void* d_ws, size_t ws_size, hipStream_t stream) {
  static int grid_blocks = 0;
  if (!grid_blocks) {
    int dev = 0, cus = 0, per_cu = 0;
    hipGetDevice(&dev);
    hipDeviceGetAttribute(&cus, hipDeviceAttributeMultiprocessorCount, dev);
    hipFuncSetAttribute((const void*)mk, hipFuncAttributeMaxDynamicSharedMemorySize, LDS_BYTES);
    hipOccupancyMaxActiveBlocksPerMultiprocessor(&per_cu, mk, NTHREADS, LDS_BYTES);
    if (per_cu < 1) per_cu = 1;
    grid_blocks = cus * per_cu;
    (void)hipGetLastError();
  }
  Params p{};
  const float** pin = (const float**)&p.x;
  for (int i = 0; i < 25; ++i) pin[i] = (const float*)d_in[i];
  p.out = (float*)d_out;
  char* w = (char*)d_ws; size_t off = 0;
  auto take = [&](size_t bytes) { char* r = w + off; off += (bytes + 255) & ~(size_t)255; return r; };
  p.X = (float*)take((size_t)MTOT * 1024 * 4);
  p.H = (bf16_t*)take((size_t)MTOT * 1024 * 2);
  p.P = (bf16_t*)take((size_t)MTOT * DIN * 2 + 4096);
  p.ACT = p.P;
  p.Q = (bf16_t*)take((size_t)MTOT * 768 * 2);
  p.Kn = (bf16_t*)take((size_t)32 * 8 * 2304 * 64 * 2);
  p.St = p.Q;
  p.Vt = (bf16_t*)take((size_t)32 * 8 * 64 * 2304 * 2);
  p.Kr = (bf16_t*)take((size_t)32 * 2304 * 32 * 2);
  p.HA = (bf16_t*)take((size_t)768 * 1024 * 2);
  p.HU = (bf16_t*)take((size_t)768 * 5632 * 2);
  p.dec = (float*)take((size_t)512 * 36 * 32 * 4);
  p.rstd = (float*)take((size_t)MTOT * 2 * 4 + 64);
  p.lnst = (float*)take((size_t)MTOT * 2 * 4);
  p.mod = (float*)take((size_t)4 * 33 * 6144 * 4);
  p.ropetab = (float*)take(2048 * 32 * 4);
  p.rettab = (float*)take(2048 * 32 * 4);
  p.Wt_in = (bf16_t*)take((size_t)2048 * 1024 * 2);
  p.Wt_uq = (bf16_t*)take((size_t)768 * 256 * 2);
  p.Wt_uk = (bf16_t*)take((size_t)512 * 256 * 2);
  p.Wt_uv = (bf16_t*)take((size_t)512 * 256 * 2);
  p.Wt_out = (bf16_t*)take((size_t)1024 * 1024 * 2);
  p.Wt_up = (bf16_t*)take((size_t)5632 * 1024 * 2);
  p.Wt_down = (bf16_t*)take((size_t)1024 * 2816 * 2);
  p.bar = (unsigned*)take((size_t)XCD_BAR_WORDS * 4 + 288 * 64);
  p.cnt = p.bar + XCD_BAR_WORDS;
  p.xch = (unsigned long long*)take((size_t)288 * 4 * 256 * 8);
  if (off > ws_size) { fprintf(stderr, "kernel_launch: workspace too small: need %zu have %zu\n", off, ws_size); return; }
  for (int i = 0; i < 8; ++i) p.ax_inv[i] = pow(10000.0, -(double)i / 8.0);
  for (int i = 0; i < 16; ++i) p.ret_inv[i] = pow(10000.0, -(double)i / 15.0);
  hipMemsetAsync(p.bar, 0, (size_t)XCD_BAR_WORDS * 4 + 288 * 64, stream);
#if MULTI_LAUNCH
  for (int ph = 0; ph < NPHASE; ++ph) {
    hipLaunchKernelGGL(mk, dim3(grid_blocks), dim3(NTHREADS), LDS_BYTES, stream, p, ph, ph + 1);
  }
#else
  int ph0 = 0, ph1 = NPHASE;
  void* args[] = {&p, &ph0, &ph1};
  hipError_t e = hipLaunchCooperativeKernel((const void*)mk, dim3(grid_blocks), dim3(NTHREADS), args, LDS_BYTES, stream);
  if (e != hipSuccess) fprintf(stderr, "cooperative launch failed: %s (grid %d)\n", hipGetErrorString(e), grid_blocks);
#endif
}
```

```cpp
#include <hip/hip_runtime.h>
#include <hip/hip_cooperative_groups.h>
#include <cstdio>
#include <cmath>
namespace cg = cooperative_groups;

#ifndef MULTI_LAUNCH
#define MULTI_LAUNCH 0
#endif

typedef unsigned short bf16_t;
typedef short bf16x8 __attribute__((ext_vector_type(8)));
typedef short bf16x4 __attribute__((ext_vector_type(4)));
typedef float f32x4 __attribute__((ext_vector_type(4)));
typedef float f32x16 __attribute__((ext_vector_type(16)));
typedef unsigned u32x4 __attribute__((ext_vector_type(4)));
typedef unsigned u32x2 __attribute__((ext_vector_type(2)));

constexpr int NLAT = 65536, NCTX = 8192, MTOT = 73728, DM = 1024, DIN = 1984, DFF = 2816;
constexpr int NTHREADS = 512;
constexpr int LDS_BYTES = 140 * 1024;
constexpr float EPS = 1e-6f;
constexpr float ALPHA = 1.681792830507429f;
constexpr int NPL = 10;
constexpr int NPHASE = 2 + 4 * NPL;
constexpr int GQ = 0, GK = 128, GV = 256, GLR = 512, GG = 544, RQ = 800, RK = 928, RV = 1056, RG = 1312, MCQ = 1568, MCKV = 1824, MKR = 1952;
constexpr int USTR = 264;

struct Params {
  const float *x, *c, *ctx, *c_ctx, *ada_w, *ada_b, *w_in, *gate_w, *gate_b, *gla_g, *ret_decay, *qn_g, *kvn_g, *w_uq, *w_uk, *w_uv,
      *w_out, *ln1_g, *ln1_b, *ffn_up, *conv_w, *conv_b, *ffn_down, *ln2_g, *ln2_b;
  float* out;
  float* X; bf16_t* H; bf16_t* P; bf16_t* HA; bf16_t* HU; bf16_t* ACT; bf16_t* Q; bf16_t* Kn; bf16_t* Vt; bf16_t* Kr; bf16_t* St; float* dec; float* rstd; float* lnst;
  float* mod; float* ropetab; float* rettab;
  bf16_t *Wt_in, *Wt_uq, *Wt_uk, *Wt_uv, *Wt_out, *Wt_up, *Wt_down;
  unsigned* bar; unsigned long long* xch; unsigned* cnt;
  double ax_inv[8]; double ret_inv[16];
};

typedef __bf16 bf2_t __attribute__((ext_vector_type(2)));
typedef float f2_t __attribute__((ext_vector_type(2)));
__device__ __forceinline__ unsigned pk2(float lo, float hi) { const f2_t v = {lo, hi}; return __builtin_bit_cast(unsigned, __builtin_convertvector(v, bf2_t)); }
__device__ __forceinline__ bf16_t f2bf(float f) { return (bf16_t)(pk2(f, 0.f) & 0xffffu); }
__device__ __forceinline__ float bf2f(bf16_t v) { return __uint_as_float(((unsigned)v) << 16); }
__device__ __forceinline__ float bflo(unsigned w) { return __uint_as_float(w << 16); }
__device__ __forceinline__ float bfhi(unsigned w) { return __uint_as_float(w & 0xffff0000u); }
__device__ __forceinline__ float silu_f(float v) { return v * __builtin_amdgcn_rcpf(1.f + __expf(-v)); }
__device__ __forceinline__ float logsigmoid_f(float z) { return fminf(z, 0.f) - __logf(1.f + __expf(-fabsf(z))); }
__device__ __forceinline__ int otid_impl(int w0) { int t; asm volatile("v_mbcnt_lo_u32_b32 %0, -1, 0\n\tv_mbcnt_hi_u32_b32 %0, -1, %0" : "=v"(t)); return w0 * 64 + t; }
#define otid() otid_impl(w0)
__device__ __forceinline__ int row_bi(int r) { return r < NLAT ? (r >> 11) : 32; }

constexpr int BM = 256, BK = 64, HALF = 128, HT = HALF * BK;
__device__ __forceinline__ int lds_byte(int r, int c) {
  int st = (r >> 4) * 2 + (c >> 5), rr = r & 15, cc = c & 31, ob = rr * 64 + cc * 2;
  return st * 1024 + (ob ^ (((ob >> 9) & 1) << 5));
}
__device__ __forceinline__ void stage_rc(int b, int& R, int& C) {
  int st = b / 1024, sb = b % 1024, swz = sb ^ (((sb >> 9) & 1) << 5);
  R = (st >> 1) * 16 + swz / 64; C = (st & 1) * 32 + (swz % 64) / 2;
}
__device__ __forceinline__ bool tile_next(long L, int nM, int nN, int& pm, int& pn) {
  int nwg = nM * nN; if (L >= nwg) return false;
  int wgid = (int)L; { int q = nwg / 8, r = nwg % 8, xcd = wgid % 8, off = wgid / 8; wgid = (xcd < r ? xcd * (q + 1) : r * (q + 1) + (xcd - r) * q) + off; }
  int nig = 8 * nN, gid = wgid / nig, fm = gid * 8, gsz = min(nM - fm, 8);
  pm = fm + ((wgid % nig) % gsz); pn = (wgid % nig) / gsz; return true;
}

__device__ __forceinline__ bool tile_next_panel(long L, int nM, int& pm, int& pn) {
  const int r = (int)(L >> 8), c = (int)(L & 255);
  pm = r * 64 + (c & 7) * 8 + (c >> 5); pn = (c >> 3) & 3;
  return pm < nM;
}
template <bool OVL, bool PANEL = false, class Epi>
__device__ __forceinline__ void gemm_phase(const bf16_t* __restrict__ A, long lda, const bf16_t* __restrict__ Bt, long ldb, int nM, int nN, int K,
                                           const Epi& epi, bf16_t* shm, int w0) {
#define SA(b, h) (shm + ((b) * 2 + (h)) * HT)
#define SB(b, h) (shm + (4 + (b) * 2 + (h)) * HT)
#define STAGE(Pp, BASE, LD, OFF, br, kt) do { const char* _gp = (const char*)((BASE) + ((long)(br) * (LD) + (long)(kt) * BK)); \
    unsigned _o = (OFF); asm volatile("" : "+v"(_o));     \
    for (int _i = 0; _i < 2; ++_i) { \
      __builtin_amdgcn_global_load_lds((const unsigned*)(_gp + (long)_i * 128 * (LD) + _o), \
        (__attribute__((address_space(3))) unsigned*)((char*)(Pp) + tid * 16 + _i * 8192), 16, 0, 0); } } while (0)
#define LDA(dst, b, h) for (int m = 0; m < 4; ++m) for (int k = 0; k < 2; ++k) \
    dst[m][k] = *reinterpret_cast<const bf16x8*>((char*)SA(b, h) + a_thr + (m * 2 + k) * 1024)
#define LDB(dst, b, h) for (int n = 0; n < 2; ++n) for (int k = 0; k < 2; ++k) \
    dst[n][k] = *reinterpret_cast<const bf16x8*>((char*)SB(b, h) + b_thr + (n * 2 + k) * 1024)
#define MMA(ai, bj, At, Btf) do { __builtin_amdgcn_s_setprio(1); \
    for (int m = 0; m < 4; ++m) for (int n = 0; n < 2; ++n) for (int k = 0; k < 2; ++k) \
      acc[ai][bj][m][n] = __builtin_amdgcn_mfma_f32_16x16x32_bf16(Btf[n][k], At[m][k], acc[ai][bj][m][n], 0, 0, 0); \
    __builtin_amdgcn_s_setprio(0); } while (0)
#define WAIT_V(n) asm volatile("s_waitcnt vmcnt(" #n ")" ::: "memory")
#define WAIT_L(n) asm volatile("s_waitcnt lgkmcnt(" #n ")" ::: "memory")
#define BAR __builtin_amdgcn_s_barrier()
#define SCHED __builtin_amdgcn_sched_barrier(0)
  const int tid = otid();
  const int wid = tid >> 6, lane = tid & 63, wr = wid >> 2, wc = wid & 3, fr = lane & 15, fq = lane >> 4;
  const int nt = K / BK;
  const int thr_sw = (fr * 64 + fq * 16) ^ ((fr >> 3) << 5); const int a_thr = wr * 8192 + thr_sw, b_thr = wc * 4096 + thr_sw;
  unsigned aoff, boff;
  { int _r, _c; stage_rc(tid * 16, _r, _c); aoff = (unsigned)((_r * lda + _c) * 2); boff = (unsigned)((_r * ldb + _c) * 2); }
  int pm, pn;
  bool have = PANEL ? tile_next_panel((long)blockIdx.x, nM, pm, pn) : tile_next((long)blockIdx.x, nM, nN, pm, pn);
  if (have) { const int brow = pm * BM, bcol = pn * BM;
    STAGE(SB(0, 0), Bt, ldb, boff, bcol, 0); STAGE(SA(0, 0), A, lda, aoff, brow, 0);
    STAGE(SB(0, 1), Bt, ldb, boff, bcol + HALF, 0); STAGE(SA(0, 1), A, lda, aoff, brow + HALF, 0); }
  for (int it = 0; have; ++it) {
    const int brow = pm * BM, bcol = pn * BM;
    f32x4 acc[2][2][4][2];
#pragma unroll
    for (int a0 = 0; a0 < 2; ++a0)
#pragma unroll
      for (int a1 = 0; a1 < 2; ++a1)
#pragma unroll
        for (int a2 = 0; a2 < 4; ++a2)
#pragma unroll
          for (int a3 = 0; a3 < 2; ++a3) acc[a0][a1][a2][a3] = (f32x4){0.f, 0.f, 0.f, 0.f};
    bf16x8 At[4][2], B0[2][2], B1[2][2];
    if (wr == 1) BAR;
    WAIT_V(4); BAR;
    STAGE(SB(1, 0), Bt, ldb, boff, bcol, 1); STAGE(SA(1, 0), A, lda, aoff, brow, 1); STAGE(SB(1, 1), Bt, ldb, boff, bcol + HALF, 1);
    WAIT_V(6); BAR;
    for (int t = 0; t < nt - 2; t += 2) {
      LDB(B0, 0, 0); SCHED; LDA(At, 0, 0); STAGE(SA(1, 1), A, lda, aoff, brow + HALF, t + 1);
      WAIT_L(8); BAR; WAIT_L(0); MMA(0, 0, At, B0); BAR; SCHED;
      LDB(B1, 0, 1); STAGE(SB(0, 0), Bt, ldb, boff, bcol, t + 2);
      BAR; WAIT_L(0); MMA(0, 1, At, B1); BAR;
      LDA(At, 0, 1); STAGE(SA(0, 0), A, lda, aoff, brow, t + 2);
      BAR; WAIT_L(0); MMA(1, 0, At, B0); BAR; SCHED;
      STAGE(SB(0, 1), Bt, ldb, boff, bcol + HALF, t + 2);
      WAIT_V(6); BAR; MMA(1, 1, At, B1); BAR;
      LDB(B0, 1, 0); SCHED; LDA(At, 1, 0); STAGE(SA(0, 1), A, lda, aoff, brow + HALF, t + 2);
      WAIT_L(8); BAR; WAIT_L(0); MMA(0, 0, At, B0); BAR; SCHED;
      LDB(B1, 1, 1); STAGE(SB(1, 0), Bt, ldb, boff, bcol, t + 3);
      BAR; WAIT_L(0); MMA(0, 1, At, B1); BAR;
      LDA(At, 1, 1); STAGE(SA(1, 0), A, lda, aoff, brow, t + 3);
      BAR; WAIT_L(0); MMA(1, 0, At, B0); BAR; SCHED;
      STAGE(SB(1, 1), Bt, ldb, boff, bcol + HALF, t + 3);
      WAIT_V(6); BAR; MMA(1, 1, At, B1); BAR;
    }
    { LDB(B0, 0, 0); LDA(At, 0, 0); STAGE(SA(1, 1), A, lda, aoff, brow + HALF, nt - 1);
      BAR; WAIT_L(0); MMA(0, 0, At, B0); BAR;
      LDB(B1, 0, 1); BAR; WAIT_L(0); MMA(0, 1, At, B1); BAR;
      LDA(At, 0, 1); WAIT_V(4); BAR; WAIT_L(0); MMA(1, 0, At, B0); MMA(1, 1, At, B1); BAR; }
    { LDB(B0, 1, 0); LDA(At, 1, 0); WAIT_V(2); BAR; WAIT_L(0); MMA(0, 0, At, B0); BAR;
      LDB(B1, 1, 1); WAIT_V(0); BAR; WAIT_L(0); MMA(0, 1, At, B1); BAR;
      LDA(At, 1, 1); BAR; WAIT_L(0); MMA(1, 0, At, B0); MMA(1, 1, At, B1); BAR; }
    if (wr == 0) BAR;
    const int cpm = pm, cpn = pn;
    have = PANEL ? tile_next_panel((long)(it + 1) * gridDim.x + blockIdx.x, nM, pm, pn) : tile_next((long)(it + 1) * gridDim.x + blockIdx.x, nM, nN, pm, pn);
    if (OVL && have) { const int nbrow = pm * BM, nbcol = pn * BM;
      STAGE(SB(0, 0), Bt, ldb, boff, nbcol, 0); STAGE(SA(0, 0), A, lda, aoff, nbrow, 0);
      STAGE(SB(0, 1), Bt, ldb, boff, nbcol + HALF, 0); STAGE(SA(0, 1), A, lda, aoff, nbrow + HALF, 0); }
    asm volatile("s_nop 15\n\ts_nop 15" ::: "memory");
    { const int tid2 = otid(); epi(acc, cpm, cpn, wr, wc, fr, fq, shm, tid2); }
    if (OVL) WAIT_V(0);
    else if (have) { const int nbrow = pm * BM, nbcol = pn * BM;
      STAGE(SB(0, 0), Bt, ldb, boff, nbcol, 0); STAGE(SA(0, 0), A, lda, aoff, nbrow, 0);
      STAGE(SB(0, 1), Bt, ldb, boff, nbcol + HALF, 0); STAGE(SA(0, 1), A, lda, aoff, nbrow + HALF, 0); }
  }
  __syncthreads();
#undef SA
#undef SB
#undef STAGE
#undef LDA
#undef LDB
#undef MMA
}

#define EPI_LOOP for (int ai = 0; ai < 2; ++ai) for (int bj = 0; bj < 2; ++bj) for (int m = 0; m < 4; ++m) for (int n = 0; n < 2; ++n)
#define EPI_RC asm volatile("" ::: "memory"); const int row = pm * 256 + ai * 128 + wr * 64 + m * 16 + fr; const int col = pn * 256 + bj * 128 + wc * 32 + n * 16 + fq * 4; const f32x4 v = acc[ai][bj][m][n];

struct EpiP {
  bf16_t* P;
  __device__ __forceinline__ void operator()(const f32x4 (&acc)[2][2][4][2], int pm, int pn, int wr, int wc, int fr, int fq, bf16_t* shm, int tid) const {
#pragma unroll
    EPI_LOOP { EPI_RC
      if (col < DIN) { u32x2 w; w.x = pk2(v[0], v[1]); w.y = pk2(v[2], v[3]); *(u32x2*)(P + (long)row * DIN + col) = w; } }
  }
};
struct EpiQ {
  bf16_t* Q; const float* rstd;
  __device__ __forceinline__ void operator()(const f32x4 (&acc)[2][2][4][2], int pm, int pn, int wr, int wc, int fr, int fq, bf16_t* shm, int tid) const {
#pragma unroll
    EPI_LOOP { EPI_RC
      const float s = rstd[2 * row] * (0.10206207261596577f * 1.4426950408889634f);
      u32x2 w; w.x = pk2(v[0] * s, v[1] * s); w.y = pk2(v[2] * s, v[3] * s); *(u32x2*)(Q + (long)row * 768 + col) = w; }
  }
};
struct EpiK {
  bf16_t* Kn; const float* rstd;
  __device__ __forceinline__ void operator()(const f32x4 (&acc)[2][2][4][2], int pm, int pn, int wr_, int wc_, int fr_, int fq_, bf16_t* shm, int tid) const {
    const int wr = tid >> 8, wc = (tid >> 6) & 3, fr = tid & 15, fq = (tid >> 4) & 3;
#pragma unroll
    EPI_LOOP { EPI_RC
      const float s = rstd[2 * row + 1];
      int b, key; if (row < NLAT) { b = row >> 11; key = row & 2047; } else { b = (row - NLAT) >> 8; key = 2048 + ((row - NLAT) & 255); }
      const int h = col >> 6, d = col & 63;
      u32x2 w; w.x = pk2(v[0] * s, v[1] * s); w.y = pk2(v[2] * s, v[3] * s);
      *(u32x2*)(Kn + (((long)(b * 8 + h) * 2304 + key) << 6) + d) = w; }
  }
};
struct EpiVt {
  bf16_t* Vt; const float* rstd;
  __device__ __forceinline__ void operator()(const f32x4 (&acc)[2][2][4][2], int pm, int pn, int wr, int wc, int fr, int fq, bf16_t* shm, int tid) const {
#pragma unroll
    for (int bj = 0; bj < 2; ++bj)
#pragma unroll
      for (int n = 0; n < 2; ++n) {
        asm volatile("" ::: "memory");
        const int col = pn * 256 + bj * 128 + wc * 32 + n * 16 + fq * 4;
        int b, key; if (col < NLAT) { b = col >> 11; key = col & 2047; } else { b = (col - NLAT) >> 8; key = 2048 + ((col - NLAT) & 255); }
        const float s0 = rstd[2 * col + 1], s1 = rstd[2 * col + 3], s2 = rstd[2 * col + 5], s3 = rstd[2 * col + 7];
        bf16_t* base = Vt + ((long)(b * 512 + pm * 256 + wr * 64 + fr)) * 2304 + key;
#pragma unroll
        for (int ai = 0; ai < 2; ++ai)
#pragma unroll
          for (int m = 0; m < 4; ++m) {
            const f32x4 v = acc[ai][bj][m][n];
            u32x2 w; w.x = pk2(v[0] * s0, v[1] * s1); w.y = pk2(v[2] * s2, v[3] * s3);
            *(u32x2*)(base + (long)(ai * 128 + m * 16) * 2304) = w;
          }
      }
  }
};
struct EpiRes {
  float* X; const float* g; const float* stats; const float* lng; const float* lnb;
  __device__ __forceinline__ void operator()(const f32x4 (&acc)[2][2][4][2], int pm, int pn, int wr_, int wc_, int fr_, int fq_, bf16_t* shm, int tid) const {
    const int wr = tid >> 8, wc = (tid >> 6) & 3, fr = tid & 15, fq = (tid >> 4) & 3;
#pragma unroll
    for (int bj = 0; bj < 2; ++bj)
#pragma unroll
      for (int n = 0; n < 2; ++n) {
        asm volatile("" ::: "memory");
        const int col = pn * 256 + bj * 128 + wc * 32 + n * 16 + fq * 4;
        f32x4 lg = {1.f, 1.f, 1.f, 1.f}, lb = {0.f, 0.f, 0.f, 0.f};
        if (stats) { lg = *(const f32x4*)(lng + col); lb = *(const f32x4*)(lnb + col); }
#pragma unroll
        for (int ai = 0; ai < 2; ++ai)
#pragma unroll
          for (int m = 0; m < 4; ++m) {
            const int row = pm * 256 + ai * 128 + wr * 64 + m * 16 + fr;
            const f32x4 v = acc[ai][bj][m][n];
            const f32x4 gv = *(const f32x4*)(g + (long)row_bi(row) * 6144 + col);
            f32x4* xp = (f32x4*)(X + (long)row * DM + col);
            f32x4 xv = *xp;
            if (stats) { const float mu = stats[2 * row], rs = stats[2 * row + 1]; xv = (xv - mu) * rs * lg + lb; }
            xv = xv * ALPHA + gv * v; *xp = xv;
          }
      }
  }
};
struct EpiResLN {
  const Params& p; int l; int fdown;
  __device__ __forceinline__ void operator()(f32x4 (&acc)[2][2][4][2], int pm, int pn, int wr_, int wc_, int fr_, int fq_, bf16_t* shm, int tid) const {
    const int wr = tid >> 8, wc = (tid >> 6) & 3, fr = tid & 15, fq = (tid >> 4) & 3;
    const bool last = (l == 3);
    const float* modl = p.mod + (long)l * 33 * 6144;
    float* X = p.X; float* lnst = p.lnst; bf16_t* H = p.H; unsigned long long* xch = p.xch; unsigned* cnt = p.cnt;
    const float* g = modl + (fdown ? 5120 : 2048);
    const float* stats = (!fdown && l == 0) ? nullptr : p.lnst;
    const float* lng = fdown ? p.ln1_g + l * 1024 : p.ln2_g + (l - 1) * 1024;
    const float* lnb = fdown ? p.ln1_b + l * 1024 : p.ln2_b + (l - 1) * 1024;
    const float* ng = fdown ? p.ln2_g + l * 1024 : p.ln1_g + l * 1024;
    const float* nb = fdown ? p.ln2_b + l * 1024 : p.ln1_b + l * 1024;
    const float* msh = fdown ? p.mod + (long)(l + 1) * 33 * 6144 : modl + 3072;
    const float* msc = fdown ? p.mod + (long)(l + 1) * 33 * 6144 + 1024 : modl + 4096;
    bf16_t* HA = fdown ? nullptr : p.HA;
    float* outp = (fdown && last) ? p.out : nullptr;
    const unsigned gen = (unsigned)(2 * l + 1 + fdown);
    const float* Xr = (!fdown && l == 0) ? (pm < 256 ? p.x : p.ctx - (long)NLAT * DM) : (const float*)X;
    const long bio = (long)row_bi(pm * 256) * 6144;
    f2_t* red = (f2_t*)((char*)shm + 128 * 1024);
    f2_t* rst = (f2_t*)((char*)shm + 128 * 1024 + 8192);
    float s1[8], s2[8];
#pragma unroll
    for (int i = 0; i < 8; ++i) { s1[i] = 0.f; s2[i] = 0.f; }
#pragma unroll
    for (int bj = 0; bj < 2; ++bj)
#pragma unroll
      for (int n = 0; n < 2; ++n) {
        asm volatile("" ::: "memory");
        const int col = pn * 256 + bj * 128 + wc * 32 + n * 16 + fq * 4;
        f32x4 lg = {1.f, 1.f, 1.f, 1.f}, lb = {0.f, 0.f, 0.f, 0.f};
        if (stats) { lg = *(const f32x4*)(lng + col); lb = *(const f32x4*)(lnb + col); }
        const f32x4 gv = *(const f32x4*)(g + bio + col);
#pragma unroll
        for (int ai = 0; ai < 2; ++ai)
#pragma unroll
          for (int m = 0; m < 4; ++m) {
            const int row = pm * 256 + ai * 128 + wr * 64 + m * 16 + fr;
            const f32x4 v = acc[ai][bj][m][n];
            f32x4* xp = (f32x4*)(X + (long)row * DM + col);
            f32x4 xv = *(const f32x4*)(Xr + (long)row * DM + col);
            if (stats) { const float mu = stats[2 * row], rs = stats[2 * row + 1]; xv = (xv - mu) * rs * lg + lb; }
            xv = xv * ALPHA + gv * v; *xp = xv;
            acc[ai][bj][m][n] = xv;
            s1[ai * 4 + m] += (xv[0] + xv[1]) + (xv[2] + xv[3]);
            s2[ai * 4 + m] += (xv[0] * xv[0] + xv[1] * xv[1]) + (xv[2] * xv[2] + xv[3] * xv[3]);
          }
      }
#pragma unroll
    for (int i = 0; i < 8; ++i) {
      s1[i] += __shfl_xor(s1[i], 16); s1[i] += __shfl_xor(s1[i], 32);
      s2[i] += __shfl_xor(s2[i], 16); s2[i] += __shfl_xor(s2[i], 32);
      if (fq == 0) red[((i >> 2) * 128 + wr * 64 + (i & 3) * 16 + fr) * 4 + wc] = (f2_t){s1[i], s2[i]};
    }
    __syncthreads();
    if (tid < 256) {
      const f2_t a = red[tid * 4], b = red[tid * 4 + 1], c = red[tid * 4 + 2], d = red[tid * 4 + 3];
      const f2_t t = {(a[0] + b[0]) + (c[0] + d[0]), (a[1] + b[1]) + (c[1] + d[1])};
      __hip_atomic_store(xch + ((long)pm * 4 + pn) * 256 + tid, __builtin_bit_cast(unsigned long long, t), __ATOMIC_RELAXED, __HIP_MEMORY_SCOPE_AGENT);
    }
    asm volatile("s_waitcnt vmcnt(0)" ::: "memory");
    __syncthreads();
    if (tid == 0) {
      __hip_atomic_fetch_add(cnt + pm * 16, 1u, __ATOMIC_RELAXED, __HIP_MEMORY_SCOPE_AGENT);
      unsigned sp = 0;
      while (__hip_atomic_load(cnt + pm * 16, __ATOMIC_RELAXED, __HIP_MEMORY_SCOPE_AGENT) < 4u * gen) { __builtin_amdgcn_s_sleep(1); if (++sp > (1u << 22)) break; }
    }
    __syncthreads();
    if (tid < 256) {
      float S1 = 0.f, S2 = 0.f;
#pragma unroll
      for (int q = 0; q < 4; ++q) { const f2_t t = __builtin_bit_cast(f2_t, __hip_atomic_load(xch + ((long)pm * 4 + q) * 256 + tid, __ATOMIC_RELAXED, __HIP_MEMORY_SCOPE_AGENT)); S1 += t[0]; S2 += t[1]; }
      const float mu = S1 * (1.f / 1024.f), var = fmaxf(S2 * (1.f / 1024.f) - mu * mu, 0.f), rs = rsqrtf(var + EPS);
      rst[tid] = (f2_t){mu, rs};
      if (pn == 0 && !outp) { lnst[2 * (pm * 256 + tid)] = mu; lnst[2 * (pm * 256 + tid) + 1] = rs; }
    }
    __syncthreads();
#pragma unroll
    for (int bj = 0; bj < 2; ++bj)
#pragma unroll
      for (int n = 0; n < 2; ++n) {
        asm volatile("" ::: "memory");
        const int col = pn * 256 + bj * 128 + wc * 32 + n * 16 + fq * 4;
        const f32x4 gg = *(const f32x4*)(ng + col), bb = *(const f32x4*)(nb + col);
        f32x4 sh = {0.f, 0.f, 0.f, 0.f}, sc = {0.f, 0.f, 0.f, 0.f};
        if (!outp) { sh = *(const f32x4*)(msh + bio + col); sc = *(const f32x4*)(msc + bio + col); }
#pragma unroll
        for (int ai = 0; ai < 2; ++ai)
#pragma unroll
          for (int m = 0; m < 4; ++m) {
            const int rl = ai * 128 + wr * 64 + m * 16 + fr, row = pm * 256 + rl;
            const f2_t st = rst[rl];
            f32x4 y = (acc[ai][bj][m][n] - st[0]) * st[1] * gg + bb;
            if (outp) { *(f32x4*)(outp + (long)row * DM + col) = y; }
            else {
              y = y * (sc + 1.f) + sh;
              u32x2 w; w.x = pk2(y[0], y[1]); w.y = pk2(y[2], y[3]);
              *(u32x2*)(H + (long)row * DM + col) = w;
              if (HA && (rl == 0 || rl == 255)) *(u32x2*)(HA + (long)(pm * 2 + (rl == 255)) * DM + col) = w;
            }
          }
      }
  }
};
struct EpiU {
  bf16_t* U;
  __device__ __forceinline__ void operator()(const f32x4 (&acc)[2][2][4][2], int pm, int pn, int wr, int wc, int fr, int fq, bf16_t* shm, int tid) const {
#pragma unroll
    EPI_LOOP { EPI_RC
      u32x2 w; w.x = pk2(v[0], v[1]); w.y = pk2(v[2], v[3]); *(u32x2*)(U + (long)row * 5632 + col) = w; }
  }
};

struct EpiConv {
  bf16_t* ACT; const bf16_t* HU; const float* cw; const float* cb;
  __device__ __forceinline__ void operator()(const f32x4 (&acc)[2][2][4][2], int pm, int pn, int wr_, int wc_, int fr_, int fq_, bf16_t* shm, int tid) const {
    bf16_t* Us = shm;
    const int wr = tid >> 8, wc = (tid >> 6) & 3, fr = tid & 15, fq = (tid >> 4) & 3;
#pragma unroll
    for (int ai = 0; ai < 2; ++ai)
#pragma unroll
      for (int bj = 0; bj < 2; ++bj)
#pragma unroll
        for (int m = 0; m < 4; ++m)
#pragma unroll
          for (int n = 0; n < 2; ++n) {
            const f32x4 v = acc[ai][bj][m][n];
            u32x2 w; w.x = pk2(v[0], v[1]); w.y = pk2(v[2], v[3]);
            *(u32x2*)(Us + (ai * 128 + wr * 64 + m * 16 + fr + 1) * USTR + bj * 128 + wc * 32 + n * 16 + fq * 4) = w;
          }
    if (tid < 64) {
      const int after = tid >> 5, c = (tid & 31) * 8;
      u32x4 hv = {0, 0, 0, 0};
      if (pm < 256) {
        if (!after && (pm & 7) != 0) hv = *(const u32x4*)(HU + (long)((pm - 1) * 2 + 1) * 5632 + pn * 256 + c);
        if (after && ((pm + 1) & 7) != 0) hv = *(const u32x4*)(HU + (long)((pm + 1) * 2) * 5632 + pn * 256 + c);
      }
      *(u32x4*)(Us + (after ? 257 : 0) * USTR + c) = hv;
    }
    __syncthreads();
    {
      const int cg = tid & 15, rs = tid >> 4, f0 = pn * 128 + cg * 8;
      float wa[3][8], wg[3][8], ba[8], bg[8];
#pragma unroll
      for (int t = 0; t < 3; ++t)
#pragma unroll
        for (int e = 0; e < 8; e += 4) {
          const f32x4 x = *(const f32x4*)(cw + t * 5632 + f0 + e), y = *(const f32x4*)(cw + t * 5632 + 2816 + f0 + e);
          wa[t][e] = x[0]; wa[t][e + 1] = x[1]; wa[t][e + 2] = x[2]; wa[t][e + 3] = x[3];
          wg[t][e] = y[0]; wg[t][e + 1] = y[1]; wg[t][e + 2] = y[2]; wg[t][e + 3] = y[3];
        }
#pragma unroll
      for (int e = 0; e < 8; e += 4) {
        const f32x4 x = *(const f32x4*)(cb + f0 + e), y = *(const f32x4*)(cb + 2816 + f0 + e);
        ba[e] = x[0]; ba[e + 1] = x[1]; ba[e + 2] = x[2]; ba[e + 3] = x[3]; bg[e] = y[0]; bg[e + 1] = y[1]; bg[e + 2] = y[2]; bg[e + 3] = y[3];
      }
      const bf16_t* up = Us + (rs * 8) * USTR + cg * 8;
      u32x4 a0 = *(const u32x4*)(up), g0 = *(const u32x4*)(up + 128), a1 = *(const u32x4*)(up + USTR), g1 = *(const u32x4*)(up + USTR + 128);
      bf16_t* outp = ACT + (long)(pm * 256 + rs * 8) * DFF + f0;
#pragma unroll
      for (int i = 0; i < 8; ++i) {
        const u32x4 a2 = *(const u32x4*)(up + (i + 2) * USTR), g2 = *(const u32x4*)(up + (i + 2) * USTR + 128);
        float res[8];
#pragma unroll
        for (int e = 0; e < 8; ++e) {
          const unsigned xa0 = a0[e >> 1], xa1 = a1[e >> 1], xa2 = a2[e >> 1], xg0 = g0[e >> 1], xg1 = g1[e >> 1], xg2 = g2[e >> 1];
          const float va0 = (e & 1) ? bfhi(xa0) : bflo(xa0), va1 = (e & 1) ? bfhi(xa1) : bflo(xa1), va2 = (e & 1) ? bfhi(xa2) : bflo(xa2);
          const float vg0 = (e & 1) ? bfhi(xg0) : bflo(xg0), vg1 = (e & 1) ? bfhi(xg1) : bflo(xg1), vg2 = (e & 1) ? bfhi(xg2) : bflo(xg2);
          const float av = va0 * wa[0][e] + va1 * wa[1][e] + va2 * wa[2][e] + ba[e];
          const float gv = vg0 * wg[0][e] + vg1 * wg[1][e] + vg2 * wg[2][e] + bg[e];
          res[e] = silu_f(av) * gv;
        }
        u32x4 w; w.x = pk2(res[0], res[1]); w.y = pk2(res[2], res[3]); w.z = pk2(res[4], res[5]); w.w = pk2(res[6], res[7]);
        *(u32x4*)(outp + (long)i * DFF) = w;
        a0 = a1; g0 = g1; a1 = a2; g1 = g2;
      }
    }
    __syncthreads();
  }
};

__device__ void mod_phase(const Params& p, float* sm, int w0) {
  const int tid = otid();
  for (int task = blockIdx.x; task < 4 * 96; task += gridDim.x) {
    const int l = task / 96, e0 = (task % 96) * 64;
    __syncthreads();
    for (int i = tid; i < 33 * 1024; i += NTHREADS) { const int bi = i >> 10, d = i & 1023; const float cv = bi < 32 ? p.c[bi * 1024 + d] : p.c_ctx[d]; sm[i] = silu_f(cv); }
    __syncthreads();
    const int kg = tid >> 6, col = tid & 63;
    float acc[33];
#pragma unroll
    for (int bi = 0; bi < 33; ++bi) acc[bi] = 0.f;
    const float* w = p.ada_w + ((long)l * 1024 + kg * 128) * 6144 + e0 + col;
    for (int d = 0; d < 128; d += 4) {
      const float w0v = w[(long)d * 6144], w1v = w[(long)(d + 1) * 6144], w2v = w[(long)(d + 2) * 6144], w3v = w[(long)(d + 3) * 6144];
#pragma unroll
      for (int bi = 0; bi < 33; ++bi) { const f32x4 sv = *(const f32x4*)(sm + bi * 1024 + kg * 128 + d); acc[bi] += (sv[0] * w0v + sv[1] * w1v) + (sv[2] * w2v + sv[3] * w3v); }
    }
    __syncthreads();
#pragma unroll
    for (int bi = 0; bi < 33; ++bi) sm[(kg * 33 + bi) * 64 + col] = acc[bi];
    __syncthreads();
    for (int i = tid; i < 33 * 64; i += NTHREADS) {
      const int bi = i >> 6, cc = i & 63; float s = p.ada_b[l * 6144 + e0 + cc];
#pragma unroll
      for (int k = 0; k < 8; ++k) s += sm[(k * 33 + bi) * 64 + cc];
      p.mod[((long)l * 33 + bi) * 6144 + e0 + cc] = s;
    }
  }
  __syncthreads();
}

__device__ __forceinline__ void sincos_d(double ang, float& c, float& s) {
  const double TWO_PI = 6.283185307179586476925;
  const double n = rint(ang / TWO_PI); const double r = ang - n * TWO_PI, r2 = r * r;
  double tc = 1.0, sc = 1.0, ts = r, ss = r;
  for (int k = 1; k <= 16; ++k) { tc *= -r2 / (double)((2 * k - 1) * (2 * k)); sc += tc; ts *= -r2 / (double)((2 * k) * (2 * k + 1)); ss += ts; }
  c = (float)sc; s = (float)ss;
}
__device__ void table_phase(const Params& p, int w0) {
  const int g = blockIdx.x * NTHREADS + otid();
  if (g < 2048 * 8) {
    const int t = g >> 3, i = g & 7; float c, s;
    sincos_d((double)(t >> 6) * p.ax_inv[i], c, s); p.ropetab[t * 32 + i] = c; p.ropetab[t * 32 + 8 + i] = s;
    sincos_d((double)(t & 63) * p.ax_inv[i], c, s); p.ropetab[t * 32 + 16 + i] = c; p.ropetab[t * 32 + 24 + i] = s;
    sincos_d((double)t * p.ret_inv[i], c, s); p.rettab[t * 32 + i] = c; p.rettab[t * 32 + 16 + i] = s;
    sincos_d((double)t * p.ret_inv[i + 8], c, s); p.rettab[t * 32 + 8 + i] = c; p.rettab[t * 32 + 24 + i] = s;
  }
}

__device__ void convert_phase(const Params& p, int l, int tbeg, int tend, float* sm, int w0) {
  const int tid = otid();
  constexpr int T0 = 512, T1 = T0 + 48, T2 = T1 + 32, T3 = T2 + 32, T4 = T3 + 256, T5 = T4 + 1408, T6 = T5 + 704;
  for (int task = tbeg + blockIdx.x; task < tend; task += gridDim.x) {
    const float* src; bf16_t* dst; int K, N, Kp, nkt, tt; const float* ksc = nullptr; int mode = 0;
    if (task < T0)      { tt = task;      src = p.w_in + (long)l * 1024 * 1984; dst = p.Wt_in; K = 1024; N = 1984; Kp = 1024; nkt = 16; }
    else if (task < T1) { tt = task - T0; src = p.w_uq + (long)l * 256 * 768; dst = p.Wt_uq; K = 256; N = 768; Kp = 256; nkt = 4; ksc = p.qn_g + l * 256; }
    else if (task < T2) { tt = task - T1; src = p.w_uk + (long)l * 128 * 512; dst = p.Wt_uk; K = 128; N = 512; Kp = 256; nkt = 4; ksc = p.kvn_g + l * 128; }
    else if (task < T3) { tt = task - T2; src = p.w_uv + (long)l * 128 * 512; dst = p.Wt_uv; K = 128; N = 512; Kp = 256; nkt = 4; ksc = p.kvn_g + l * 128; }
    else if (task < T4) { tt = task - T3; src = p.w_out + (long)l * 1024 * 1024; dst = p.Wt_out; K = 1024; N = 1024; Kp = 1024; nkt = 16; }
    else if (task < T5) { tt = task - T4; src = p.ffn_up + (long)l * 1024 * 5632; dst = p.Wt_up; K = 1024; N = 5632; Kp = 1024; nkt = 16; mode = 1; }
    else                { tt = task - T5; src = p.ffn_down + (long)l * 2816 * 1024; dst = p.Wt_down; K = 2816; N = 1024; Kp = 2816; nkt = 44; }
    const int n0 = (tt / nkt) * 64, k0 = (tt % nkt) * 64;
    int c0 = n0;
    if (mode == 1) { const int pn = n0 >> 8, j = n0 & 255; c0 = j < 128 ? pn * 128 + j : 2816 + pn * 128 + (j - 128); }
    __syncthreads();
#pragma unroll
    for (int i = 0; i < 8; ++i) {
      const int kk = (tid >> 6) + 8 * i, nn = tid & 63; float v = 0.f;
      if (k0 + kk < K && n0 + nn < N) { v = src[(long)(k0 + kk) * N + c0 + nn]; if (ksc) v *= ksc[k0 + kk]; }
      sm[kk * 65 + nn] = v;
    }
    __syncthreads();
    { const int nn = tid >> 3, kk0 = (tid & 7) * 8; u32x4 w;
      w.x = pk2(sm[(kk0 + 0) * 65 + nn], sm[(kk0 + 1) * 65 + nn]); w.y = pk2(sm[(kk0 + 2) * 65 + nn], sm[(kk0 + 3) * 65 + nn]);
      w.z = pk2(sm[(kk0 + 4) * 65 + nn], sm[(kk0 + 5) * 65 + nn]); w.w = pk2(sm[(kk0 + 6) * 65 + nn], sm[(kk0 + 7) * 65 + nn]);
      *(u32x4*)(dst + (long)(n0 + nn) * Kp + k0 + kk0) = w; }
  }
  __syncthreads();
}

__device__ void ln_phase(const Params& p, int mode, int l, int w0) {
  const int tid = otid(); const int lane = tid & 63, wv = tid >> 6;
  const bool fin = (mode == 2 && l == 3);
  const int nrows = (mode == 0 || (mode == 2 && l < 3) || (mode == 1 && l < 3)) ? MTOT : NLAT;
  const float* lg = mode == 1 ? p.ln1_g + l * 1024 : p.ln2_g + l * 1024;
  const float* lb = mode == 1 ? p.ln1_b + l * 1024 : p.ln2_b + l * 1024;
  const int ml = mode == 0 ? 0 : (mode == 1 ? l : l + 1);
  const int shoff = mode == 1 ? 3072 : 0, scoff = mode == 1 ? 4096 : 1024;
  for (int rb = blockIdx.x * 16 + wv * 2; rb < nrows; rb += gridDim.x * 16) {
    f32x4 v[2][4];
#pragma unroll
    for (int u = 0; u < 2; ++u) {
      const int r = rb + u;
      const float* src = mode == 0 ? (r < NLAT ? p.x + (long)r * 1024 : p.ctx + (long)(r - NLAT) * 1024) : p.X + (long)r * 1024;
#pragma unroll
      for (int i = 0; i < 4; ++i) v[u][i] = __builtin_nontemporal_load((const f32x4*)(src + i * 256 + lane * 4));
    }
#pragma unroll
    for (int u = 0; u < 2; ++u) {
      const int r = rb + u;
      if (mode == 0) {
      } else {
        float s = 0.f;
#pragma unroll
        for (int i = 0; i < 4; ++i) s += (v[u][i][0] + v[u][i][1]) + (v[u][i][2] + v[u][i][3]);
#pragma unroll
        for (int o = 32; o > 0; o >>= 1) s += __shfl_xor(s, o);
        const float mu = s * (1.f / 1024.f); float q = 0.f;
#pragma unroll
        for (int i = 0; i < 4; ++i) { v[u][i] = v[u][i] - mu; q += (v[u][i][0] * v[u][i][0] + v[u][i][1] * v[u][i][1]) + (v[u][i][2] * v[u][i][2] + v[u][i][3] * v[u][i][3]); }
#pragma unroll
        for (int o = 32; o > 0; o >>= 1) q += __shfl_xor(q, o);
        const float rs = rsqrtf(q * (1.f / 1024.f) + EPS);
        if (lane == 0 && !fin) { p.lnst[2 * r] = mu; p.lnst[2 * r + 1] = rs; }
#pragma unroll
        for (int i = 0; i < 4; ++i) { const f32x4 g = *(const f32x4*)(lg + i * 256 + lane * 4), bb = *(const f32x4*)(lb + i * 256 + lane * 4); v[u][i] = v[u][i] * rs * g + bb; }
      }
      if (fin) {
#pragma unroll
        for (int i = 0; i < 4; ++i) *(f32x4*)(p.out + (long)r * 1024 + i * 256 + lane * 4) = v[u][i];
      } else {
        const float* mb = p.mod + ((long)ml * 33 + row_bi(r)) * 6144;
#pragma unroll
        for (int i = 0; i < 4; ++i) {
          const f32x4 sh = *(const f32x4*)(mb + shoff + i * 256 + lane * 4), sc = *(const f32x4*)(mb + scoff + i * 256 + lane * 4);
          const f32x4 h = v[u][i] * (sc + 1.f) + sh;
          u32x2 w; w.x = pk2(h[0], h[1]); w.y = pk2(h[2], h[3]);
          *(u32x2*)(p.H + (long)r * 1024 + i * 256 + lane * 4) = w;
          if (mode == 1 && ((r & 255) == 0 || (r & 255) == 255)) *(u32x2*)(p.HA + (long)((r >> 8) * 2 + ((r & 255) == 255)) * 1024 + i * 256 + lane * 4) = w;
        }
      }
    }
  }
}

__device__ void mlaprep_phase(const Params& p, int w0) {
  const int tid = otid(); const int lane = tid & 63, wv = tid >> 6;
  for (int r = blockIdx.x * 8 + wv; r < MTOT; r += gridDim.x * 8) {
    const bf16_t* pr = p.P + (long)r * DIN;
    const u32x2 cq = *(const u32x2*)(pr + MCQ + lane * 4);
    const unsigned ck = *(const unsigned*)(pr + MCKV + lane * 2);
    float sq = bflo(cq.x) * bflo(cq.x) + bfhi(cq.x) * bfhi(cq.x) + bflo(cq.y) * bflo(cq.y) + bfhi(cq.y) * bfhi(cq.y);
    float sk = bflo(ck) * bflo(ck) + bfhi(ck) * bfhi(ck);
#pragma unroll
    for (int o = 32; o > 0; o >>= 1) { sq += __shfl_xor(sq, o); sk += __shfl_xor(sk, o); }
    if (lane == 0) { p.rstd[2 * r] = rsqrtf(sq * (1.f / 256.f) + EPS); p.rstd[2 * r + 1] = rsqrtf(sk * (1.f / 128.f) + EPS); }
    const float kv = bf2f(pr[MKR + (lane & 31)]);
    float outv = kv; int b, key;
    if (r < NLAT) {
      b = r >> 11; key = r & 2047;
      const float other = __shfl_xor(kv, 8);
      const int i = lane & 7, part = (lane >> 4) & 1;
      const float cs = p.ropetab[key * 32 + part * 16 + i], sn = p.ropetab[key * 32 + part * 16 + 8 + i];
      outv = (lane & 8) ? (other * sn + kv * cs) : (kv * cs - other * sn);
    } else { b = (r - NLAT) >> 8; key = 2048 + ((r - NLAT) & 255); }
    if (lane < 32) p.Kr[((long)b * 2304 + key) * 32 + lane] = f2bf(outv);
  }
}

constexpr int SSTR = 72;
__device__ __forceinline__ int chunk_row0(int b, int c) { return c < 4 ? NLAT + b * 256 + c * 64 : b * 2048 + (c - 4) * 64; }
__device__ __forceinline__ f32x4 mma16(const bf16_t* A, const bf16_t* B, f32x4 acc, int fr, int fq) {
  const bf16x8 a = *(const bf16x8*)(A + fr * SSTR + fq * 8), b = *(const bf16x8*)(B + fr * SSTR + fq * 8);
  return __builtin_amdgcn_mfma_f32_16x16x32_bf16(a, b, acc, 0, 0, 0);
}

__device__ __forceinline__ long state_idx(int mx, int b, int h, int dir, int c) { return ((((long)(mx * 32 + b) * 4 + h) * 2 + dir) * 36 + c); }

struct ScanPre { u32x2 kw, qw, kp, qp, lw; u32x4 vw, gw; f32x4 cs, sn; float w[16]; float bias; u32x4 st; };

template <bool C>
__device__ __forceinline__ void scan_fetch(const Params& p, int l, int task, int tid, ScanPre& R) {
  const int c = task % 36, h = (task / 36) & 3, b = (task / 144) & 31, mx = task / 4608;
  const int row0 = chunk_row0(b, c);
  const int qoff = (mx ? RQ : GQ) + h * 32, koff = (mx ? RK : GK) + h * 32, voff = (mx ? RV : GV) + h * 64;
  const int s = tid >> 3, d0 = (tid & 7) * 4;
  const bf16_t* pr = p.P + (long)(row0 + s) * DIN;
  R.kw = *(const u32x2*)(pr + koff + d0);
  if (C) R.qw = *(const u32x2*)(pr + qoff + d0);
  if (mx == 1 && c >= 4) {
    const int dp = d0 ^ 16, i0 = d0 & 15, t = (c - 4) * 64 + s;
    R.kp = *(const u32x2*)(pr + koff + dp);
    if (C) R.qp = *(const u32x2*)(pr + qoff + dp);
    R.cs = *(const f32x4*)(p.rettab + t * 32 + i0); R.sn = *(const f32x4*)(p.rettab + t * 32 + 16 + i0);
  }
  R.vw = *(const u32x4*)(pr + voff + (tid & 7) * 8);
  const int gd = tid & 31, gdir = (tid >> 5) & 1;
  if (mx == 0) {
    R.lw = *(const u32x2*)(pr + GLR + d0);
#pragma unroll
    for (int r = 0; r < 16; ++r) R.w[r] = p.gate_w[(((long)l * 2 + gdir) * 16 + r) * 128 + h * 32 + gd];
    R.bias = p.gate_b[((long)l * 2 + gdir) * 128 + h * 32 + gd];
  } else R.bias = p.ret_decay[((long)l * 2 + gdir) * 4 + h];
  if (C) {
    R.gw = *(const u32x4*)(pr + (mx ? RG : GG) + h * 64 + (tid & 7) * 8);
    R.st = *(const u32x4*)(p.St + state_idx(mx, b, h, tid >> 8, c) * 2048 + (tid & 255) * 8);
  }
}

template <bool C>
__device__ __forceinline__ void scan_stage1(const ScanPre& R, int mx, int c, int tid, float* lrs, bf16_t* VT, float (&kv)[4], float (&qv)[4]) {
  const int s = tid >> 3, d0 = (tid & 7) * 4;
  kv[0] = bflo(R.kw.x); kv[1] = bfhi(R.kw.x); kv[2] = bflo(R.kw.y); kv[3] = bfhi(R.kw.y);
  qv[0] = qv[1] = qv[2] = qv[3] = 0.f;
  if (C) { qv[0] = bflo(R.qw.x); qv[1] = bfhi(R.qw.x); qv[2] = bflo(R.qw.y); qv[3] = bfhi(R.qw.y); }
  if (mx == 1 && c >= 4) {
    const float kpv[4] = {bflo(R.kp.x), bfhi(R.kp.x), bflo(R.kp.y), bfhi(R.kp.y)};
    float qpv[4] = {0.f, 0.f, 0.f, 0.f};
    if (C) { qpv[0] = bflo(R.qp.x); qpv[1] = bfhi(R.qp.x); qpv[2] = bflo(R.qp.y); qpv[3] = bfhi(R.qp.y); }
#pragma unroll
    for (int j = 0; j < 4; ++j) {
      const float cs = R.cs[j], sn = R.sn[j];
      if (d0 < 16) { kv[j] = kv[j] * cs - kpv[j] * sn; qv[j] = qv[j] * cs - qpv[j] * sn; }
      else         { kv[j] = kpv[j] * sn + kv[j] * cs; qv[j] = qpv[j] * sn + qv[j] * cs; }
    }
  }
  const int e0 = (tid & 7) * 8;
#pragma unroll
  for (int j = 0; j < 4; ++j) { VT[(e0 + 2 * j) * SSTR + s] = (bf16_t)(R.vw[j] & 0xffffu); VT[(e0 + 2 * j + 1) * SSTR + s] = (bf16_t)(R.vw[j] >> 16); }
  if (mx == 0) { *(f32x4*)(lrs + s * 32 + d0) = (f32x4){bflo(R.lw.x), bfhi(R.lw.x), bflo(R.lw.y), bfhi(R.lw.y)}; }
}

__device__ __forceinline__ void scan_stage2(const ScanPre& R, int mx, int tid, const float* lrs, float* tot, float (&a)[8]) {
  const int d = tid & 31, dir = (tid >> 5) & 1, sg = tid >> 6;
  if (mx == 0) {
#pragma unroll
    for (int j = 0; j < 8; ++j) {
      float z = R.bias;
#pragma unroll
      for (int r = 0; r < 16; r += 4) { const f32x4 lv = *(const f32x4*)(lrs + (sg * 8 + j) * 32 + dir * 16 + r); z += lv[0] * R.w[r] + lv[1] * R.w[r + 1] + lv[2] * R.w[r + 2] + lv[3] * R.w[r + 3]; }
      a[j] = logsigmoid_f(z) * (1.f / 16.f);
    }
  } else {
    const float lg = logsigmoid_f(R.bias);
#pragma unroll
    for (int j = 0; j < 8; ++j) a[j] = lg;
  }
  if (dir == 0) {
#pragma unroll
    for (int j = 1; j < 8; ++j) a[j] += a[j - 1];
  } else {
#pragma unroll
    for (int j = 6; j >= 0; --j) a[j] += a[j + 1];
  }
  tot[sg * 64 + dir * 32 + d] = dir == 0 ? a[7] : a[0];
}
__device__ __forceinline__ void scan_stage3(int tid, const float* tot, float* bc, const float (&a)[8]) {
  const int d = tid & 31, dir = (tid >> 5) & 1, sg = tid >> 6;
  float off = 0.f;
#pragma unroll
  for (int g = 0; g < 8; ++g) { const float tv = tot[g * 64 + dir * 32 + d]; if (dir == 0 ? (g < sg) : (g > sg)) off += tv; }
#pragma unroll
  for (int j = 0; j < 8; ++j) bc[(dir * 64 + sg * 8 + j) * 32 + d] = a[j] + off;
}

__device__ void scanA_phase(const Params& p, int l, char* shm, int w0) {
  float* bc = (float*)shm; float* lrs = bc + 4096; float* tot = lrs + 2048;
  bf16_t* VT = (bf16_t*)(tot + 512); bf16_t* KHT = VT + 64 * SSTR;
  const int tid = otid(), wv = tid >> 6, lane = tid & 63, fr = lane & 15, fq = lane >> 4;
  const int NT = 2 * 32 * 4 * 36;
  ScanPre R;
  int task = blockIdx.x;
  if (task < NT) scan_fetch<false>(p, l, task, tid, R);
  for (; task < NT; task += gridDim.x) {
    const int c = task % 36, h = (task / 36) & 3, b = (task / 144) & 31, mx = task / 4608;
    float kv[4], qv[4], a[8];
    __syncthreads();
    scan_stage1<false>(R, mx, c, tid, lrs, VT, kv, qv);
    __syncthreads();
    scan_stage2(R, mx, tid, lrs, tot, a);
    if (task + (int)gridDim.x < NT) scan_fetch<false>(p, l, task + gridDim.x, tid, R);
    __syncthreads();
    scan_stage3(tid, tot, bc, a);
    __syncthreads();
    { const int s = tid >> 3, d0 = (tid & 7) * 4;
#pragma unroll
      for (int dir = 0; dir < 2; ++dir) {
        const f32x4 bv = *(const f32x4*)(bc + (dir * 64 + s) * 32 + d0), be = *(const f32x4*)(bc + (dir * 64 + (dir ? 0 : 63)) * 32 + d0);
#pragma unroll
        for (int j = 0; j < 4; ++j) KHT[(dir * 32 + d0 + j) * SSTR + s] = f2bf(kv[j] * __expf(be[j] - bv[j]));
      }
      if (tid < 64) { const int d = tid & 31, dir = tid >> 5; p.dec[state_idx(mx, b, h, dir, c) * 32 + d] = __expf(bc[(dir * 64 + (dir ? 0 : 63)) * 32 + d]); }
    }
    __syncthreads();
#pragma unroll
    for (int q = 0; q < 2; ++q) {
      const int id = wv * 2 + q, dir = id >> 3, dti = (id >> 2) & 1, eti = id & 3;
      f32x4 acc = {0.f, 0.f, 0.f, 0.f};
#pragma unroll
      for (int ks = 0; ks < 2; ++ks) acc = mma16(KHT + (dir * 32 + dti * 16) * SSTR + ks * 32, VT + (eti * 16) * SSTR + ks * 32, acc, fr, fq);
      asm volatile("s_nop 15\n\ts_nop 15" : "+v"(acc[0]), "+v"(acc[1]), "+v"(acc[2]), "+v"(acc[3]));
      u32x2 wst; wst.x = pk2(acc[0], acc[1]); wst.y = pk2(acc[2], acc[3]);
      *(u32x2*)(p.St + state_idx(mx, b, h, dir, c) * 2048 + (eti * 16 + fr) * 32 + dti * 16 + fq * 4) = wst;
    }
  }
  __syncthreads();
}

__device__ void scanB_phase(const Params& p, int w0) {
  const int tid = otid();
  for (int task = blockIdx.x; task < 512 * 2; task += gridDim.x) {
    const int chain = task >> 1, i = ((task & 1) * 512 + tid) * 2, d = i & 31, dir = chain & 1;
    bf16_t* st = p.St + (long)chain * 36 * 2048 + i; const float* dc = p.dec + (long)chain * 36 * 32 + d;
    unsigned loc[36]; float dv0[36], dv1[36];
#pragma unroll
    for (int k = 0; k < 36; ++k) { const int c = dir == 0 ? k : (k < 4 ? 3 - k : 39 - k); loc[k] = *(const unsigned*)(st + (long)c * 2048); dv0[k] = dc[c * 32]; dv1[k] = dc[c * 32 + 1]; }
    float r0 = 0.f, r1 = 0.f;
#pragma unroll
    for (int k = 0; k < 36; ++k) { const int c = dir == 0 ? k : (k < 4 ? 3 - k : 39 - k); *(unsigned*)(st + (long)c * 2048) = pk2(r0, r1); r0 = r0 * dv0[k] + bflo(loc[k]); r1 = r1 * dv1[k] + bfhi(loc[k]); }
  }
}

__device__ void scanC_phase(const Params& p, int l, bool last, char* shm, int w0) {
  float* bc = (float*)shm; float* lrs = bc + 4096; float* tot = lrs + 2048;
  bf16_t* VT = (bf16_t*)(tot + 512); bf16_t* QFB = VT + 64 * SSTR; bf16_t* KFB = QFB + 64 * SSTR; bf16_t* ST = KFB + 64 * SSTR; bf16_t* ATT = ST + 64 * SSTR;
  float* O = (float*)(ATT + 64 * SSTR);
  const int tid = otid(), wv = tid >> 6, lane = tid & 63, fr = lane & 15, fq = lane >> 4;
  const float qscale = 0.17677669529663687f;
  const int NT = 2 * 32 * 4 * 36, G = gridDim.x;
  auto nextt = [&](int t) { t += G; while (last && t < NT && (t % 36) < 4) t += G; return t; };
  ScanPre R;
  int task = (int)blockIdx.x - G; task = nextt(task);
  if (task < NT) scan_fetch<true>(p, l, task, tid, R);
  for (; task < NT;) {
    const int c = task % 36, h = (task / 36) & 3, b = (task / 144) & 31, mx = task / 4608;
    const int ntask = nextt(task);
    float kv[4], qv[4], a[8];
    __syncthreads();
    scan_stage1<true>(R, mx, c, tid, lrs, VT, kv, qv);
    { const int idx = (tid & 255) * 8; *(u32x4*)(ST + (idx >> 5) * SSTR + (tid >> 8) * 32 + (idx & 31)) = R.st; }
    const u32x4 gw = R.gw;
    __syncthreads();
    scan_stage2(R, mx, tid, lrs, tot, a);
    if (ntask < NT) scan_fetch<true>(p, l, ntask, tid, R);
    __syncthreads();
    scan_stage3(tid, tot, bc, a);
    __syncthreads();
    { const int s = tid >> 3, d0 = (tid & 7) * 4;
#pragma unroll
      for (int dir = 0; dir < 2; ++dir) {
        const f32x4 bv = *(const f32x4*)(bc + (dir * 64 + s) * 32 + d0);
        float qx[4], kx[4];
#pragma unroll
        for (int j = 0; j < 4; ++j) { qx[j] = qv[j] * qscale * __expf(bv[j]); kx[j] = kv[j] * __expf(-bv[j]); }
        u32x2 wq, wk; wq.x = pk2(qx[0], qx[1]); wq.y = pk2(qx[2], qx[3]); wk.x = pk2(kx[0], kx[1]); wk.y = pk2(kx[2], kx[3]);
        *(u32x2*)(QFB + s * SSTR + dir * 32 + d0) = wq; *(u32x2*)(KFB + s * SSTR + dir * 32 + d0) = wk;
      }
    }
    __syncthreads();
#pragma unroll
    for (int q = 0; q < 2; ++q) {
      const int id = wv * 2 + q, tt = id >> 2, ts = id & 3;
      f32x4 af = {0.f, 0.f, 0.f, 0.f}, ab = {0.f, 0.f, 0.f, 0.f};
      if (ts <= tt) af = mma16(QFB + tt * 16 * SSTR, KFB + ts * 16 * SSTR, af, fr, fq);
      if (ts >= tt) ab = mma16(QFB + tt * 16 * SSTR + 32, KFB + ts * 16 * SSTR + 32, ab, fr, fq);
#pragma unroll
      for (int j = 0; j < 4; ++j) {
        const int t = tt * 16 + fq * 4 + j, s = ts * 16 + fr;
        const float v = (s <= t ? af[j] : 0.f) + (s >= t ? ab[j] : 0.f);
        ATT[t * SSTR + s] = f2bf(v);
      }
    }
    __syncthreads();
#pragma unroll
    for (int q = 0; q < 2; ++q) {
      const int id = wv * 2 + q, tt = id >> 2, et = id & 3;
      f32x4 acc = {0.f, 0.f, 0.f, 0.f};
#pragma unroll
      for (int ks = 0; ks < 2; ++ks) {
        acc = mma16(ATT + tt * 16 * SSTR + ks * 32, VT + et * 16 * SSTR + ks * 32, acc, fr, fq);
        acc = mma16(QFB + tt * 16 * SSTR + ks * 32, ST + et * 16 * SSTR + ks * 32, acc, fr, fq);
      }
#pragma unroll
      for (int j = 0; j < 4; ++j) O[(tt * 16 + fq * 4 + j) * 65 + et * 16 + fr] = acc[j];
    }
    __syncthreads();
    { const int t = tid >> 3, e0 = (tid & 7) * 8; float o[8]; float s = 0.f;
#pragma unroll
      for (int j = 0; j < 8; ++j) { o[j] = O[t * 65 + e0 + j]; s += o[j]; }
      s += __shfl_xor(s, 1); s += __shfl_xor(s, 2); s += __shfl_xor(s, 4);
      const float mu = mx == 1 ? s * (1.f / 64.f) : 0.f; float qq = 0.f;
#pragma unroll
      for (int j = 0; j < 8; ++j) { o[j] -= mu; qq += o[j] * o[j]; }
      qq += __shfl_xor(qq, 1); qq += __shfl_xor(qq, 2); qq += __shfl_xor(qq, 4);
      const float rs = rsqrtf(qq * (1.f / 64.f) + EPS);
      const int row = chunk_row0(b, c) + t;
      float r[8];
#pragma unroll
      for (int j = 0; j < 8; ++j) {
        const unsigned w = gw[j >> 1]; const float gt = (j & 1) ? bfhi(w) : bflo(w);
        float y = o[j] * rs; if (mx == 0) y *= p.gla_g[l * 64 + e0 + j];
        r[j] = y * silu_f(gt);
      }
      u32x4 w; w.x = pk2(r[0], r[1]); w.y = pk2(r[2], r[3]); w.z = pk2(r[4], r[5]); w.w = pk2(r[6], r[7]);
      *(u32x4*)(p.H + (long)row * 1024 + mx * 256 + h * 64 + e0) = w;
    }
    task = ntask;
  }
  __syncthreads();
}

constexpr int KSTR = 104, VSTR = 72;
__device__ void attn_phase(const Params& p, bool last, char* shm, int w0) {
  bf16_t* Ks = (bf16_t*)shm;
  bf16_t* Vs = Ks + 2 * 64 * KSTR;
  const int tid = otid(), wv = tid >> 6, lane = tid & 63, lq = lane & 31, hb = lane >> 5;
  const int ntask = 1024 + (last ? 0 : 256);
  for (int task = blockIdx.x; task < ntask; task += gridDim.x) {
    int b, h, qrow0, nkeys, key0, nwav;
    if (task < 1024) { b = task >> 5; h = (task >> 2) & 7; qrow0 = b * 2048 + (task & 3) * 512; nkeys = 2304; key0 = 0; nwav = 8; }
    else { const int t = task - 1024; b = t >> 3; h = t & 7; qrow0 = NLAT + b * 256; nkeys = 256; key0 = 2048; nwav = 4; }
    const bool act = wv < nwav;
    bf16x8 qf[2][6];
    if (act) {
#pragma unroll
      for (int qt = 0; qt < 2; ++qt) {
        const int row = qrow0 + wv * 64 + qt * 32 + lq; const bf16_t* qp = p.Q + (long)row * 768 + h * 96;
#pragma unroll
        for (int ks = 0; ks < 4; ++ks) qf[qt][ks] = *(const bf16x8*)(qp + ks * 16 + hb * 8);
#pragma unroll
        for (int ks = 4; ks < 6; ++ks) {
          const bf16x8 own = *(const bf16x8*)(qp + ks * 16 + hb * 8);
          if (task < 1024) {
            const bf16x8 oth = *(const bf16x8*)(qp + ks * 16 + (hb ^ 1) * 8);
            const int t = row & 2047; const float* tb = p.ropetab + t * 32 + (ks - 4) * 16;
            bf16x8 r;
#pragma unroll
            for (int i = 0; i < 8; i += 2) {
              const float cs0 = tb[i], sn0 = tb[8 + i], cs1 = tb[i + 1], sn1 = tb[9 + i];
              const float o0 = bf2f((bf16_t)own[i]), o1 = bf2f((bf16_t)own[i + 1]), x0 = bf2f((bf16_t)oth[i]), x1 = bf2f((bf16_t)oth[i + 1]);
              const float r0 = hb ? (x0 * sn0 + o0 * cs0) : (o0 * cs0 - x0 * sn0);
              const float r1 = hb ? (x1 * sn1 + o1 * cs1) : (o1 * cs1 - x1 * sn1);
              const unsigned w = pk2(r0, r1); r[i] = (short)(w & 0xffffu); r[i + 1] = (short)(w >> 16);
            }
            qf[qt][ks] = r;
          } else qf[qt][ks] = own;
        }
      }
    }
    f32x16 ot[2][2];
#pragma unroll
    for (int i = 0; i < 2; ++i)
#pragma unroll
      for (int j = 0; j < 2; ++j)
#pragma unroll
        for (int e = 0; e < 16; ++e) ot[i][j][e] = 0.f;
    float mrun[2] = {0.f, 0.f}, lrun[2] = {0.f, 0.f};
    const bf16_t* Kng = p.Kn + ((long)(b * 8 + h) * 2304 + key0) * 64;
    const bf16_t* Krg = p.Kr + ((long)b * 2304 + key0) * 32;
    const bf16_t* Vtg = p.Vt + ((long)(b * 8 + h) * 64) * 2304 + key0;
    const unsigned offk = (unsigned)tid * 16u, offr = (unsigned)(tid & 255) * 16u, offv = (unsigned)((tid >> 3) * 2304 + (tid & 7) * 8) * 2u;
    const int lk0 = (tid >> 3) * KSTR + (tid & 7) * 8, lk1 = ((tid & 255) >> 2) * KSTR + 64 + (tid & 3) * 8, lv = (tid >> 3) * VSTR + (tid & 7) * 8;
    u32x4 rk0, rk1 = {0, 0, 0, 0}, rv;
    auto gload = [&](int kt) {
      rk0 = *(const u32x4*)((const char*)Kng + (size_t)kt * 8192 + offk);
      if (tid < 256) rk1 = *(const u32x4*)((const char*)Krg + (size_t)kt * 4096 + offr);
      rv = *(const u32x4*)((const char*)Vtg + (size_t)kt * 128 + offv);
    };
    auto lstore = [&](int buf) {
      *(u32x4*)(Ks + buf * 64 * KSTR + lk0) = rk0;
      if (tid < 256) *(u32x4*)(Ks + buf * 64 * KSTR + lk1) = rk1;
      *(u32x4*)(Vs + buf * 64 * VSTR + lv) = rv;
    };
    const int ntile = nkeys / 64;
    __syncthreads();
    gload(0); lstore(0);
    __syncthreads();
    for (int kt = 0; kt < ntile; ++kt) {
      const int buf = kt & 1;
      if (kt + 1 < ntile) gload(kt + 1);
      if (act) {
        const bf16_t* Kb = Ks + buf * 64 * KSTR; const bf16_t* Vb = Vs + buf * 64 * VSTR;
#pragma unroll
        for (int k2 = 0; k2 < 2; ++k2) {
          f32x16 st[2];
#pragma unroll
          for (int j = 0; j < 2; ++j)
#pragma unroll
            for (int e = 0; e < 16; ++e) st[j][e] = -mrun[j];
#pragma unroll
          for (int ks = 0; ks < 6; ++ks) {
            const bf16x8 kf = *(const bf16x8*)(Kb + (k2 * 32 + lq) * KSTR + ks * 16 + hb * 8);
            st[0] = __builtin_amdgcn_mfma_f32_32x32x16_bf16(kf, qf[0][ks], st[0], 0, 0, 0);
            st[1] = __builtin_amdgcn_mfma_f32_32x32x16_bf16(kf, qf[1][ks], st[1], 0, 0, 0);
          }
          bf16x8 pf[2][2];
#pragma unroll
          for (int qt = 0; qt < 2; ++qt) {
            float mx = st[qt][0];
#pragma unroll
            for (int e = 1; e < 16; ++e) mx = fmaxf(mx, st[qt][e]);
            mx = fmaxf(mx, __shfl_xor(mx, 32));
            const bool first = (kt == 0 && k2 == 0);
            if (first || __builtin_amdgcn_ballot_w64(mx > 6.f) != 0ull) {
              const float delta = first ? mx : fmaxf(mx, 0.f);
              const float alpha = first ? 1.f : __builtin_amdgcn_exp2f(-delta);
              mrun[qt] += delta;
#pragma unroll
              for (int e = 0; e < 16; ++e) st[qt][e] -= delta;
              lrun[qt] *= alpha;
#pragma unroll
              for (int dt = 0; dt < 2; ++dt)
#pragma unroll
                for (int e = 0; e < 16; ++e) ot[dt][qt][e] *= alpha;
            }
            float ls = 0.f;
#pragma unroll
            for (int s2 = 0; s2 < 2; ++s2) {
              const int g0 = s2 * 2; bf16x8 f;
#pragma unroll
              for (int j = 0; j < 4; j += 2) {
                const float p0 = __builtin_amdgcn_exp2f(st[qt][g0 * 4 + j]), p1 = __builtin_amdgcn_exp2f(st[qt][g0 * 4 + j + 1]);
                const float p2 = __builtin_amdgcn_exp2f(st[qt][(g0 + 1) * 4 + j]), p3 = __builtin_amdgcn_exp2f(st[qt][(g0 + 1) * 4 + j + 1]);
                ls += (p0 + p1) + (p2 + p3);
                const unsigned ww0 = pk2(p0, p1), ww1 = pk2(p2, p3);
                f[j] = (short)(ww0 & 0xffffu); f[j + 1] = (short)(ww0 >> 16); f[4 + j] = (short)(ww1 & 0xffffu); f[4 + j + 1] = (short)(ww1 >> 16);
              }
              pf[qt][s2] = f;
            }
            lrun[qt] += ls;
          }
#pragma unroll
          for (int dt = 0; dt < 2; ++dt)
#pragma unroll
            for (int s2 = 0; s2 < 2; ++s2) {
              const bf16_t* vp = Vb + (dt * 32 + lq) * VSTR + (k2 * 2 + s2) * 16 + hb * 4;
              const bf16x4 v0 = *(const bf16x4*)vp, v1 = *(const bf16x4*)(vp + 8);
              bf16x8 vf; vf[0] = v0[0]; vf[1] = v0[1]; vf[2] = v0[2]; vf[3] = v0[3]; vf[4] = v1[0]; vf[5] = v1[1]; vf[6] = v1[2]; vf[7] = v1[3];
              ot[dt][0] = __builtin_amdgcn_mfma_f32_32x32x16_bf16(vf, pf[0][s2], ot[dt][0], 0, 0, 0);
              ot[dt][1] = __builtin_amdgcn_mfma_f32_32x32x16_bf16(vf, pf[1][s2], ot[dt][1], 0, 0, 0);
            }
        }
      }
      if (kt + 1 < ntile) lstore(buf ^ 1);
      __syncthreads();
    }
    if (act) {
#pragma unroll
      for (int qt = 0; qt < 2; ++qt) {
        const float lt = lrun[qt] + __shfl_xor(lrun[qt], 32); const float inv = 1.f / lt;
        const int row = qrow0 + wv * 64 + qt * 32 + lq; bf16_t* op = p.H + (long)row * 1024 + 512 + h * 64;
#pragma unroll
        for (int dt = 0; dt < 2; ++dt)
#pragma unroll
          for (int g = 0; g < 4; ++g) {
            u32x2 w; w.x = pk2(ot[dt][qt][g * 4] * inv, ot[dt][qt][g * 4 + 1] * inv); w.y = pk2(ot[dt][qt][g * 4 + 2] * inv, ot[dt][qt][g * 4 + 3] * inv);
            *(u32x2*)(op + dt * 32 + g * 8 + hb * 4) = w;
          }
      }
    }
  }
  __syncthreads();
}

#define XB_TMO      128
#define XB_XCNT(j)  (256  + 64 * (j))
#define XB_XSUB(j)  (1280 + 64 * (j))
#define XB_XGEN(j)  (2304 + 64 * (j))
#define XB_TOP      3328
#define XB_TOPGEN   3392
#define XCD_BAR_WORDS 3456
#define XB_SPIN_CAP (1u << 18)
#define LAS __attribute__((address_space(3)))
__device__ __forceinline__ unsigned xb_ld(unsigned* p)              { return __hip_atomic_load(p, __ATOMIC_RELAXED, __HIP_MEMORY_SCOPE_AGENT); }
__device__ __forceinline__ unsigned xb_add(unsigned* p, unsigned v) { return __hip_atomic_fetch_add(p, v, __ATOMIC_RELAXED, __HIP_MEMORY_SCOPE_AGENT); }
__device__ __forceinline__ unsigned xb_xcc_id() { return (unsigned)__builtin_amdgcn_s_getreg((3 << 11) | 20) & 0xFu; }
#define XB_SPIN(cond, bar) do { unsigned _sp = 0; while (cond) { __builtin_amdgcn_s_sleep(1); \
    if ((++_sp & 255u) == 0u) { if (xb_ld(&(bar)[XB_TMO])) break; if (_sp > XB_SPIN_CAP) { atomicAdd(&(bar)[XB_TMO], 1u); break; } } } } while (0)
struct XcdBarrier { unsigned* bar; unsigned x; volatile LAS unsigned* st; };
__device__ __forceinline__ XcdBarrier xcd_barrier_post(unsigned* bar, volatile LAS unsigned* st, int tid) {
  XcdBarrier b; b.bar = bar; b.x = xb_xcc_id(); b.st = st;
  if (tid == 0) (void)xb_add(&bar[XB_XCNT(b.x)], 1u);
  return b;
}
__device__ __forceinline__ void xcd_barrier_complete(unsigned* bar, unsigned x, unsigned& nloc, unsigned& nx) {
  const unsigned G = gridDim.x * gridDim.y * gridDim.z;
  unsigned sum, cnt, mine, sp = 0u;
  for (;;) {
    sum = 0u; cnt = 0u; mine = 0u;
#pragma unroll
    for (unsigned j = 0; j < 16; ++j) { const unsigned c = xb_ld(&bar[XB_XCNT(j)]); sum += c; cnt += (c > 0u) ? 1u : 0u; mine = (j == x) ? c : mine; }
    if (sum == G) break;
    __builtin_amdgcn_s_sleep(1);
    if ((++sp & 255u) == 0u) { if (xb_ld(&bar[XB_TMO])) break; if (sp > XB_SPIN_CAP) { atomicAdd(&bar[XB_TMO], 1u); break; } }
  }
  nloc = mine > 0u ? mine : 1u; nx = cnt > 0u ? cnt : 1u;
}
__device__ __forceinline__ void xcd_barrier(unsigned* bar_, volatile LAS unsigned* st_, int tid) {
  XcdBarrier b; b.bar = bar_; b.st = st_; b.x = xb_xcc_id();
  asm volatile("s_waitcnt vmcnt(0)" ::: "memory");
  __syncthreads();
  if (tid == 0) {
    unsigned* bar = b.bar;
    __builtin_amdgcn_s_waitcnt(0);
    unsigned nloc = b.st[0], nx = b.st[1];
    if (nloc == 0u) { xcd_barrier_complete(bar, b.x, nloc, nx); b.st[0] = nloc; b.st[1] = nx; }
    const unsigned old = xb_add(&bar[XB_XSUB(b.x)], 1u);
    const unsigned gen = old / nloc;
    if (old + 1u == (gen + 1u) * nloc) {
      __builtin_amdgcn_fence(__ATOMIC_RELEASE, "agent");
      asm volatile("s_waitcnt vmcnt(0)" ::: "memory");
      const unsigned og = xb_add(&bar[XB_TOP], 1u);
      const unsigned tg = og / nx;
      if (og + 1u == (tg + 1u) * nx) xb_add(&bar[XB_TOPGEN], 1u);
      else XB_SPIN(xb_ld(&bar[XB_TOPGEN]) == tg, bar);
      __builtin_amdgcn_fence(__ATOMIC_ACQUIRE, "agent");
      xb_add(&bar[XB_XGEN(b.x)], 1u);
      asm volatile("s_waitcnt vmcnt(0)" ::: "memory");
    } else {
      XB_SPIN(xb_ld(&bar[XB_XGEN(b.x)]) == gen, bar);
      __builtin_amdgcn_fence(__ATOMIC_ACQUIRE, "agent");
      asm volatile("s_waitcnt vmcnt(0)" ::: "memory");
    }
  }
  __syncthreads();
}

__device__ void run_phase(const Params& p, int ph, char* shm, int w0) {
  if (ph == 0) { mod_phase(p, (float*)shm, w0); table_phase(p, w0); convert_phase(p, 0, 0, 2992, (float*)shm, w0); return; }
  if (ph == 1) { ln_phase(p, 0, 0, w0); return; }
  const int l = (ph - 2) / NPL, s = (ph - 2) % NPL; const bool last = (l == 3);
  const float* modl = p.mod + (long)l * 33 * 6144;
  bf16_t* sh = (bf16_t*)shm;
  switch (s) {
    case 0: { EpiP e{p.P}; gemm_phase<true>(p.H, 1024, p.Wt_in, 1024, MTOT / 256, 8, 1024, e, sh, w0); } break;
    case 1: scanA_phase(p, l, shm, w0); mlaprep_phase(p, w0); if (l > 0) convert_phase(p, l, 2288, 2992, (float*)shm, w0); break;
    case 2: { scanB_phase(p, w0); EpiVt e{p.Vt, p.rstd}; gemm_phase<true>(p.Wt_uv, 256, p.P + MCKV, DIN, 2, MTOT / 256, 128, e, sh, w0); } break;
    case 3: scanC_phase(p, l, last, shm, w0); break;
    case 4: { EpiQ e{p.Q, p.rstd}; gemm_phase<true>(p.P + MCQ, DIN, p.Wt_uq, 256, (last ? NLAT : MTOT) / 256, 3, 256, e, sh, w0);
              EpiK e2{p.Kn, p.rstd}; gemm_phase<true>(p.P + MCKV, DIN, p.Wt_uk, 256, MTOT / 256, 2, 128, e2, sh, w0); } break;
    case 5: attn_phase(p, last, shm, w0); break;
    case 6: { EpiResLN e{p, l, 0}; gemm_phase<true, true>(p.H, 1024, p.Wt_out, 1024, (last ? NLAT : MTOT) / 256, 4, 1024, e, sh, w0); } break;
    case 7: { EpiU e{p.HU}; gemm_phase<true>(p.HA, 1024, p.Wt_up, 1024, 3, 22, 1024, e, sh, w0);
              if (!last) convert_phase(p, l + 1, 0, 880, (float*)shm, w0); } break;
    case 8: { EpiConv e{p.ACT, p.HU, p.conv_w + (long)l * 3 * 5632, p.conv_b + (long)l * 5632}; gemm_phase<false>(p.H, 1024, p.Wt_up, 1024, (last ? NLAT : MTOT) / 256, 22, 1024, e, sh, w0); } break;
    case 9: { EpiResLN e{p, l, 1}; gemm_phase<true, true>(p.ACT, DFF, p.Wt_down, DFF, (last ? NLAT : MTOT) / 256, 4, DFF, e, sh, w0);
              if (!last) convert_phase(p, l + 1, 880, 2288, (float*)shm, w0); } break;
  }
}

__global__ void __launch_bounds__(NTHREADS) mk(Params p, int ph0, int ph1) {
  extern __shared__ __attribute__((aligned(16))) char shm[];
  __shared__ uint4 xb_words;
  cg::grid_group grid = cg::this_grid();
  const int w0 = __builtin_amdgcn_readfirstlane((int)(threadIdx.x >> 6));
  {
    const int tid = otid();
    if (tid == 0) xb_words = make_uint4(0u, 0u, 0u, 0u);
    __syncthreads();
  }
  { const int tid = otid(); (void)xcd_barrier_post(p.bar, (volatile LAS unsigned*)&xb_words, tid); }
  if (ph1 < 0) grid.sync();
  for (int ph = ph0; ph < ph1; ++ph) {
    run_phase(p, ph, shm, w0);
    if (ph + 1 < ph1) {
      { const int tid = otid(); xcd_barrier(p.bar, (volatile LAS unsigned*)&xb_words, tid); }
    }
  }
}

extern "C" void kernel_launch(void* const* d_in, const int* in_sizes, int n_in, void* d_out, int out_size, void* d_ws, size_t ws_size, hipStream_t stream) {
  static int grid_blocks = 0;
  if (!grid_blocks) {
    int dev = 0, cus = 0, per_cu = 0;
    hipGetDevice(&dev);
    hipDeviceGetAttribute(&cus, hipDeviceAttributeMultiprocessorCount, dev);
    hipFuncSetAttribute((const void*)mk, hipFuncAttributeMaxDynamicSharedMemorySize, LDS_BYTES);
    hipOccupancyMaxActiveBlocksPerMultiprocessor(&per_cu, mk, NTHREADS, LDS_BYTES);
    if (per_cu < 1) per_cu = 1;
    grid_blocks = cus * per_cu;
    (void)hipGetLastError();
  }
  Params p{};
  const float** pin = (const float**)&p.x;
  for (int i = 0; i < 25; ++i) pin[i] = (const float*)d_in[i];
  p.out = (float*)d_out;
  char* w = (char*)d_ws; size_t off = 0;
  auto take = [&](size_t bytes) { char* r = w + off; off += (bytes + 255) & ~(size_t)255; return r; };
  p.X = (float*)take((size_t)MTOT * 1024 * 4);
  p.H = (bf16_t*)take((size_t)MTOT * 1024 * 2);
  p.P = (bf16_t*)take((size_t)MTOT * DIN * 2 + 4096);
  p.ACT = p.P;
  p.Q = (bf16_t*)take((size_t)MTOT * 768 * 2);
  p.Kn = (bf16_t*)take((size_t)32 * 8 * 2304 * 64 * 2);
  p.St = p.Q;
  p.Vt = (bf16_t*)take((size_t)32 * 8 * 64 * 2304 * 2);
  p.Kr = (bf16_t*)take((size_t)32 * 2304 * 32 * 2);
  p.HA = (bf16_t*)take((size_t)768 * 1024 * 2);
  p.HU = (bf16_t*)take((size_t)768 * 5632 * 2);
  p.dec = (float*)take((size_t)512 * 36 * 32 * 4);
  p.rstd = (float*)take((size_t)MTOT * 2 * 4 + 64);
  p.lnst = (float*)take((size_t)MTOT * 2 * 4);
  p.mod = (float*)take((size_t)4 * 33 * 6144 * 4);
  p.ropetab = (float*)take(2048 * 32 * 4);
  p.rettab = (float*)take(2048 * 32 * 4);
  p.Wt_in = (bf16_t*)take((size_t)2048 * 1024 * 2);
  p.Wt_uq = (bf16_t*)take((size_t)768 * 256 * 2);
  p.Wt_uk = (bf16_t*)take((size_t)512 * 256 * 2);
  p.Wt_uv = (bf16_t*)take((size_t)512 * 256 * 2);
  p.Wt_out = (bf16_t*)take((size_t)1024 * 1024 * 2);
  p.Wt_up = (bf16_t*)take((size_t)5632 * 1024 * 2);
  p.Wt_down = (bf16_t*)take((size_t)1024 * 2816 * 2);
  p.bar = (unsigned*)take((size_t)XCD_BAR_WORDS * 4 + 288 * 64);
  p.cnt = p.bar + XCD_BAR_WORDS;
  p.xch = (unsigned long long*)take((size_t)288 * 4 * 256 * 8);
  if (off > ws_size) { fprintf(stderr, "kernel_launch: workspace too small: need %zu have %zu\n", off, ws_size); return; }
  for (int i = 0; i < 8; ++i) p.ax_inv[i] = pow(10000.0, -(double)i / 8.0);
  for (int i = 0; i < 16; ++i) p.ret_inv[i] = pow(10000.0, -(double)i / 15.0);
  hipMemsetAsync(p.bar, 0, (size_t)XCD_BAR_WORDS * 4 + 288 * 64, stream);
#if MULTI_LAUNCH
  for (int ph = 0; ph < NPHASE; ++ph) {
    hipLaunchKernelGGL(mk, dim3(grid_blocks), dim3(NTHREADS), LDS_BYTES, stream, p, ph, ph + 1);
  }
#else
  int ph0 = 0, ph1 = NPHASE;
  void* args[] = {&p, &ph0, &ph1};
  hipError_t e = hipLaunchCooperativeKernel((const void*)mk, dim3(grid_blocks), dim3(NTHREADS), args, LDS_BYTES, stream);
  if (e != hipSuccess) fprintf(stderr, "cooperative launch failed: %s (grid %d)\n", hipGetErrorString(e), grid_blocks);
#endif
}
```
